# Optimizing an MI355X kernel written in HIP

```python
import jax, jax.numpy as jnp
from jax import lax
import numpy as np

D_MODEL = 1024
BATCH = 4
SEQ = 8192
DEPTH = 1

HG_HEADS = 8
HG_DK = 128
HG_DV = D_MODEL // HG_HEADS
HG_DIM_K = HG_HEADS * HG_DK
HG_DIM_V = HG_HEADS * HG_DV
RET_HEADS = 4
RET_DK = 256
RET_DV = 256
RET_DIM_K = RET_HEADS * RET_DK
RET_DIM_V = RET_HEADS * RET_DV
ROPE_BASE = 10000.0
MAX_POS_OFFSET = 4096
CHUNK = 64
PROJ_WIDTHS = (HG_DIM_K, HG_DIM_K, HG_DIM_K, HG_DIM_V, HG_DIM_V, RET_DIM_K, RET_DIM_K, RET_DIM_V, RET_DIM_V, D_MODEL, D_MODEL)
PROJ_DIM = HG_DIM_K * 3 + HG_DIM_V * 2 + RET_DIM_K * 2 + RET_DIM_V * 2 + D_MODEL * 2
N_GROUPS = 4
EXPERTS_PER_GROUP = 8
N_EXPERTS = N_GROUPS * EXPERTS_PER_GROUP
TOP_K = 2
D_EXPERT = 512
MOE_BLOCK = 128
DEEPNORM_ALPHA = (2 * DEPTH) ** 0.25
DEEPNORM_BETA = (8 * DEPTH) ** -0.25
LN_EPS = 1e-5
RMS_EPS = 1e-6

kernel_name = 'hybrid_hgrn2_retention_hmoe_deepnorm'


def _layer_norm(x, g, b):
    xf = x.astype(jnp.float32)
    mu = jnp.mean(xf, -1, keepdims=True)
    var = jnp.mean(jnp.square(xf - mu), -1, keepdims=True)
    return ((xf - mu) * lax.rsqrt(var + LN_EPS) * g + b).astype(x.dtype)


def _rms_norm_heads(o, g):
    of = o.astype(jnp.float32)
    of = of * lax.rsqrt(jnp.mean(of * of, -1, keepdims=True) + RMS_EPS)
    return of.reshape(*o.shape[:-2], -1) * g


def _to_chunks(t):
    b, l, h, d = t.shape
    return t.reshape(b, l // CHUNK, CHUNK, h, d).transpose(1, 0, 3, 2, 4)


def _from_chunks(t):
    n, b, h, c, d = t.shape
    return t.transpose(1, 0, 3, 2, 4).reshape(b, n * c, h, d)


def _hgrn2_scan(q, k, v, log_f):
    dt = v.dtype
    qc, kc, vc, lfc = (_to_chunks(t.astype(jnp.float32)) for t in (q, k, v, log_f))
    b, h, dk, dv = qc.shape[1], qc.shape[2], qc.shape[-1], vc.shape[-1]
    causal = jnp.tril(jnp.ones((CHUNK, CHUNK), bool))[:, :, None]

    def step(S, inp):
        qb, kb, vb, lf = inp
        G = jnp.cumsum(lf, axis=2)
        g_last = G[:, :, -1:, :]
        decay = jnp.exp(jnp.where(causal, G[:, :, :, None, :] - G[:, :, None, :, :], -jnp.inf))
        attn = jnp.einsum('bhtd,bhsd,bhtsd->bhts', qb, kb, decay)
        o = jnp.einsum('bhts,bhsv->bhtv', attn, vb) + jnp.einsum('bhtd,bhdv->bhtv', qb * jnp.exp(G), S)
        S = jnp.exp(g_last[:, :, 0, :, None]) * S + jnp.einsum('bhsd,bhsv->bhdv', kb * jnp.exp(g_last - G), vb)
        return S, o

    S0 = jnp.zeros((b, h, dk, dv), jnp.float32)
    _, o = lax.scan(step, S0, (qc, kc, vc, lfc))
    return _from_chunks(o).astype(dt)


def _retention_scan(q, k, v, log_gamma):
    dt = v.dtype
    qc, kc, vc = (_to_chunks(t.astype(jnp.float32)) for t in (q, k, v))
    b, h, dk, dv = qc.shape[1], qc.shape[2], qc.shape[-1], vc.shape[-1]
    idx = jnp.arange(CHUNK, dtype=jnp.float32)
    rel = idx[:, None] - idx[None, :]
    lg = log_gamma[:, None]
    decay = jnp.where(rel >= 0, jnp.exp(jnp.maximum(rel, 0.0) * log_gamma[:, None, None]), 0.0)
    cross = jnp.exp((idx + 1.0) * lg)[:, :, None]
    k_dec = jnp.exp((CHUNK - 1.0 - idx) * lg)[:, :, None]
    chunk_dec = jnp.exp(CHUNK * log_gamma)[:, None, None]

    def step(R, inp):
        qb, kb, vb = inp
        inner = jnp.einsum('bhtd,bhsd->bhts', qb, kb) * decay
        o = jnp.einsum('bhts,bhsv->bhtv', inner, vb) + cross * jnp.einsum('bhtd,bhdv->bhtv', qb, R)
        R = chunk_dec * R + jnp.einsum('bhsd,bhsv->bhdv', kb * k_dec, vb)
        return R, o

    R0 = jnp.zeros((b, h, dk, dv), jnp.float32)
    _, o = lax.scan(step, R0, (qc, kc, vc))
    return _from_chunks(o).astype(dt)


def _rotary(t, positions):
    d = t.shape[-1]
    inv = 1.0 / (ROPE_BASE ** jnp.linspace(0.0, 1.0, d // 2, dtype=jnp.float32))
    ang = positions.astype(jnp.float32)[..., None] * inv
    sin, cos = jnp.sin(ang)[:, :, None, :], jnp.cos(ang)[:, :, None, :]
    tf = t.astype(jnp.float32)
    t1, t2 = tf[..., 0::2], tf[..., 1::2]
    out = jnp.stack([t1 * cos - t2 * sin, t1 * sin + t2 * cos], axis=-1).reshape(t.shape)
    return out.astype(t.dtype)


def _token_mixer(x, positions, w_in, lb, hg_norm_g, ret_norm_g, w_branch_hg, w_branch_ret, w_out):
    b, l, _ = x.shape
    proj = x @ w_in
    hq, hf_fwd, hf_bwd, hi, hgate, rq, rk, rv, rgate, ga, gb = jnp.split(proj, np.cumsum(PROJ_WIDTHS)[:-1].tolist(), axis=-1)
    heads = lambda t, n: t.reshape(b, l, n, -1)
    flip = lambda t: jnp.flip(t, axis=1)

    q_h = heads(jax.nn.silu(hq), HG_HEADS)
    v_h = heads(hi, HG_HEADS)

    def hgrn_direction(f_logits, qd, vd):
        f = lb + (1.0 - lb) * jax.nn.sigmoid(f_logits.astype(jnp.float32))
        return _hgrn2_scan(qd, heads(1.0 - f, HG_HEADS), vd, heads(jnp.log(f), HG_HEADS))

    o_hg = hgrn_direction(hf_fwd, q_h, v_h) + flip(hgrn_direction(flip(hf_bwd), flip(q_h), flip(v_h)))
    o_hg = _rms_norm_heads(o_hg, hg_norm_g) * jax.nn.silu(hgate.astype(jnp.float32))
    y_hg = o_hg.astype(x.dtype) @ w_branch_hg

    rq_h = _rotary(heads(rq, RET_HEADS), positions)
    rk_h = _rotary(heads(rk, RET_HEADS), positions) * RET_DK ** -0.5
    rv_h = heads(rv, RET_HEADS)
    log_gamma = jnp.log(1.0 - 2.0 ** (-5.0 - jnp.arange(RET_HEADS, dtype=jnp.float32)))
    o_ret = _retention_scan(rq_h, rk_h, rv_h, log_gamma) + flip(_retention_scan(flip(rq_h), flip(rk_h), flip(rv_h), log_gamma))
    o_ret = _rms_norm_heads(o_ret, ret_norm_g) * jax.nn.silu(rgate.astype(jnp.float32))
    y_ret = o_ret.astype(x.dtype) @ w_branch_ret

    merged = jax.nn.sigmoid(ga) * y_hg + jax.nn.sigmoid(gb) * y_ret
    return merged @ w_out


def _hier_moe(x, w_group, b_group, w_router, b_router, w1, w3, w2):
    t, d = x.shape
    g_logits = (x @ w_group).astype(jnp.float32) + b_group
    grp = jnp.argmax(g_logits, -1)
    p_grp = jnp.take_along_axis(jax.nn.softmax(g_logits, -1), grp[:, None], -1)
    e_logits = ((x @ w_router).astype(jnp.float32) + b_router).reshape(t, N_GROUPS, EXPERTS_PER_GROUP)
    e_logits = jnp.take_along_axis(e_logits, grp[:, None, None], 1)[:, 0]
    top_p, top_i = lax.top_k(jax.nn.softmax(e_logits, -1), TOP_K)
    top_p = top_p / jnp.sum(top_p, -1, keepdims=True)
    wts = (p_grp * top_p).reshape(-1)
    eid = (grp[:, None] * EXPERTS_PER_GROUP + top_i).reshape(-1)
    n_assign = t * TOP_K
    tok = jnp.arange(n_assign, dtype=jnp.int32) // TOP_K

    order = jnp.argsort(eid)
    e_sorted = eid[order]
    counts = jnp.zeros((N_EXPERTS,), jnp.int32).at[eid].add(1)
    start = jnp.cumsum(counts) - counts
    padded = (counts + MOE_BLOCK - 1) // MOE_BLOCK * MOE_BLOCK
    pend = jnp.cumsum(padded)
    pstart = pend - padded
    dest = pstart[e_sorted] + (jnp.arange(n_assign, dtype=jnp.int32) - start[e_sorted])
    n_blocks = -(-n_assign // MOE_BLOCK) + N_EXPERTS
    rows = jnp.full((n_blocks * MOE_BLOCK,), t, jnp.int32).at[dest].set(tok[order])
    row_w = jnp.zeros((n_blocks * MOE_BLOCK,), jnp.float32).at[dest].set(wts[order])
    block_expert = jnp.clip(jnp.searchsorted(pend, jnp.arange(n_blocks, dtype=jnp.int32) * MOE_BLOCK, side='right'), 0, N_EXPERTS - 1)
    x_pad = jnp.concatenate([x, jnp.zeros((1, d), x.dtype)], 0)
    xb = x_pad[rows].reshape(n_blocks, MOE_BLOCK, d)

    def expert_block(args):
        xs, e = args
        return (jax.nn.silu(xs @ w1[e]) * (xs @ w3[e])) @ w2[e]

    yb = lax.map(expert_block, (xb, block_expert))
    y = yb.reshape(-1, d) * row_w[:, None].astype(x.dtype)
    return jax.ops.segment_sum(y, rows, num_segments=t + 1)[:t]


def setup_inputs(seed: int = 0) -> dict:
    key = jax.random.key(seed)
    ks = jax.random.split(key, 20)
    nrm = lambda k, shape, s: jax.random.normal(k, shape, jnp.float32) * s
    beta = DEEPNORM_BETA
    x = nrm(ks[0], (BATCH, SEQ, D_MODEL), 1.0)
    positions = jax.random.randint(ks[1], (BATCH, 1), 0, MAX_POS_OFFSET, jnp.int32) + jnp.arange(SEQ, dtype=jnp.int32)[None, :]
    col_scales = (1.0, 1.0, 1.0, beta, 1.0, 1.0, 1.0, beta, 1.0, 1.0, 1.0)
    col_scale = jnp.concatenate([jnp.full((w,), s, jnp.float32) for w, s in zip(PROJ_WIDTHS, col_scales)])
    w_in = nrm(ks[2], (DEPTH, D_MODEL, PROJ_DIM), D_MODEL ** -0.5) * col_scale
    hg_lb_logits = nrm(ks[3], (DEPTH + 1, HG_DIM_K), 0.5)
    hg_norm_g = 1.0 + nrm(ks[4], (DEPTH, HG_DIM_V), 0.02)
    ret_norm_g = 1.0 + nrm(ks[5], (DEPTH, RET_DIM_V), 0.02)
    w_branch_hg = nrm(ks[6], (DEPTH, HG_DIM_V, D_MODEL), HG_DIM_V ** -0.5 * beta)
    w_branch_ret = nrm(ks[7], (DEPTH, RET_DIM_V, D_MODEL), RET_DIM_V ** -0.5 * beta)
    w_out = nrm(ks[8], (DEPTH, D_MODEL, D_MODEL), D_MODEL ** -0.5 * beta)
    ln1_g = 1.0 + nrm(ks[9], (DEPTH, D_MODEL), 0.02)
    ln1_b = nrm(ks[10], (DEPTH, D_MODEL), 0.02)
    w_group = nrm(ks[11], (DEPTH, D_MODEL, N_GROUPS), D_MODEL ** -0.5)
    b_group = nrm(ks[12], (DEPTH, N_GROUPS), 0.01)
    w_router = nrm(ks[13], (DEPTH, D_MODEL, N_EXPERTS), D_MODEL ** -0.5)
    b_router = nrm(ks[14], (DEPTH, N_EXPERTS), 0.01)
    w1 = nrm(ks[15], (DEPTH, N_EXPERTS, D_MODEL, D_EXPERT), D_MODEL ** -0.5)
    w3 = nrm(ks[16], (DEPTH, N_EXPERTS, D_MODEL, D_EXPERT), D_MODEL ** -0.5)
    w2 = nrm(ks[17], (DEPTH, N_EXPERTS, D_EXPERT, D_MODEL), D_EXPERT ** -0.5 * beta)
    ln2_g = 1.0 + nrm(ks[18], (DEPTH, D_MODEL), 0.02)
    ln2_b = nrm(ks[19], (DEPTH, D_MODEL), 0.02)
    return {'x': x, 'positions': positions, 'w_in': w_in, 'hg_lb_logits': hg_lb_logits,
            'hg_norm_g': hg_norm_g, 'ret_norm_g': ret_norm_g, 'w_branch_hg': w_branch_hg,
            'w_branch_ret': w_branch_ret, 'w_out': w_out, 'ln1_g': ln1_g, 'ln1_b': ln1_b,
            'w_group': w_group, 'b_group': b_group, 'w_router': w_router, 'b_router': b_router,
            'w1': w1, 'w3': w3, 'w2': w2, 'ln2_g': ln2_g, 'ln2_b': ln2_b}


def reference(x, positions, w_in, hg_lb_logits, hg_norm_g, ret_norm_g, w_branch_hg, w_branch_ret,
              w_out, ln1_g, ln1_b, w_group, b_group, w_router, b_router, w1, w3, w2, ln2_g, ln2_b):
    lb_cum = jnp.cumsum(jax.nn.softmax(hg_lb_logits.astype(jnp.float32), axis=0), axis=0)
    for layer in range(DEPTH):
        lb = lb_cum[layer + 1] - lb_cum[0]
        mix = _token_mixer(x, positions, w_in[layer], lb, hg_norm_g[layer], ret_norm_g[layer],
                           w_branch_hg[layer], w_branch_ret[layer], w_out[layer])
        x = _layer_norm(DEEPNORM_ALPHA * x + mix, ln1_g[layer], ln1_b[layer])
        moe = _hier_moe(x.reshape(-1, D_MODEL), w_group[layer], b_group[layer], w_router[layer],
                        b_router[layer], w1[layer], w3[layer], w2[layer]).reshape(x.shape)
        x = _layer_norm(DEEPNORM_ALPHA * x + moe, ln2_g[layer], ln2_b[layer])
    return x
```

```cpp
#include <hip/hip_runtime.h>
#include <hip/hip_cooperative_groups.h>
#include <cstdio>
#include <cstdint>
namespace cg = cooperative_groups;
#define LAS __attribute__((address_space(3)))
typedef unsigned short bf16_t;
typedef short bf16x8 __attribute__((ext_vector_type(8)));
typedef float f32x4 __attribute__((ext_vector_type(4)));
typedef unsigned u32x4 __attribute__((ext_vector_type(4)));
typedef unsigned u32x2 __attribute__((ext_vector_type(2)));

constexpr int T_TOK = 32768, DM = 1024, SEQ = 8192;
constexpr size_t MiB = 1u << 20;
constexpr size_t TD = (size_t)T_TOK * DM;
constexpr float ALPHA = 1.189207115002721f;
constexpr float LN_EPS = 1e-5f, RMS_EPS = 1e-6f;
constexpr size_t OFF_CTL = 0;
constexpr size_t OFF_GCNT = 16384;
constexpr size_t OFF_LB = 64 * 1024;
constexpr size_t OFF_INV = 80 * 1024;
constexpr size_t OFF_WRT = 128 * 1024;
constexpr size_t OFF_WIN = 1 * MiB;
constexpr size_t OFF_WBH = 23 * MiB, OFF_WBR = 25 * MiB, OFF_WO = 27 * MiB;
constexpr size_t OFF_U0 = 32 * MiB;
constexpr size_t USZ = 64 * MiB;
constexpr size_t USTR = USZ + 152320;
constexpr size_t OFF_XB = OFF_U0 + 6 * USTR;
constexpr size_t OFF_SP = OFF_XB + USTR;
static_assert(OFF_SP + 28 * MiB <= 512 * MiB, "workspace map exceeds the contract's 512 MiB");
constexpr size_t OFF_LENT = OFF_SP, OFF_LW = OFF_SP + 4 * MiB;
constexpr size_t OFF_RG2 = OFF_SP + 12 * MiB;
constexpr int RG2_PANELS = 32, RG2_ROWS = RG2_PANELS * 256;
constexpr int LCAP = 32768;
constexpr int CTL_ZERO_BYTES = 32768;
constexpr int LDS_BYTES = 152 * 1024;
constexpr int LDS_MISC = 144 * 1024;
constexpr int LDS_XB = LDS_BYTES - 64;

typedef __bf16 bf16v2_t __attribute__((ext_vector_type(2)));
typedef float f32v2_t __attribute__((ext_vector_type(2)));
__device__ __forceinline__ unsigned pk2(float lo, float hi) { const f32v2_t v = {lo, hi}; const bf16v2_t b = __builtin_convertvector(v, bf16v2_t); return __builtin_bit_cast(unsigned, b); }
__device__ __forceinline__ float bflo(unsigned w) { return __uint_as_float(w << 16); }
__device__ __forceinline__ float bfhi(unsigned w) { return __uint_as_float(w & 0xffff0000u); }
__device__ __forceinline__ float bf2f(bf16_t h) { return __uint_as_float(((unsigned)h) << 16); }
__device__ __forceinline__ float sigmoidf_(float x) { return __builtin_amdgcn_rcpf(1.0f + __expf(-x)); }
__device__ __forceinline__ float siluf_(float x) { return x * __builtin_amdgcn_rcpf(1.0f + __expf(-x)); }
template <int CTRL> __device__ __forceinline__ float dpp_f(float v) { return __builtin_bit_cast(float, __builtin_amdgcn_update_dpp(0, __builtin_bit_cast(int, v), CTRL, 0xF, 0xF, false)); }
__device__ __forceinline__ float sum_lanes8(float v) { v += dpp_f<0xB1>(v); v += dpp_f<0x4E>(v); v += dpp_f<0x141>(v); return v; }
__device__ __forceinline__ float sum_lanes16(float v) { v = sum_lanes8(v); v += dpp_f<0x140>(v); return v; }
__device__ __forceinline__ float wave_sum(float v) {
    const int r = __builtin_bit_cast(int, sum_lanes16(v));
    const float a = __builtin_bit_cast(float, __builtin_amdgcn_readlane(r, 0)), b = __builtin_bit_cast(float, __builtin_amdgcn_readlane(r, 16));
    const float c = __builtin_bit_cast(float, __builtin_amdgcn_readlane(r, 32)), d = __builtin_bit_cast(float, __builtin_amdgcn_readlane(r, 48));
    return (a + b) + (c + d);
}

#define XB_TMO      128
#define XB_XCNT(j)  (256  + 64 * (j))
#define XB_XSUB(j)  (1280 + 64 * (j))
#define XB_XGEN(j)  (2304 + 64 * (j))
#define XB_TOP      3328
#define XB_TOPGEN   3392
#define XCD_BAR_WORDS 3456
#define XB_SPIN_CAP (1u << 20)
__device__ __forceinline__ unsigned xb_ld(unsigned* p)              { return __hip_atomic_load(p, __ATOMIC_RELAXED, __HIP_MEMORY_SCOPE_AGENT); }
__device__ __forceinline__ unsigned xb_add(unsigned* p, unsigned v) { return __hip_atomic_fetch_add(p, v, __ATOMIC_RELAXED, __HIP_MEMORY_SCOPE_AGENT); }
__device__ __forceinline__ unsigned xb_xcc_id() { return (unsigned)__builtin_amdgcn_s_getreg((3 << 11) | 20) & 0xFu; }
#define XB_SPIN(cond, bar) do { unsigned _sp = 0; while (cond) { __builtin_amdgcn_s_sleep(1); \
    if ((++_sp & 255u) == 0u) { if (xb_ld(&(bar)[XB_TMO])) break; if (_sp > XB_SPIN_CAP) { atomicAdd(&(bar)[XB_TMO], 1u); break; } } } } while (0)
struct XcdBarrier { unsigned* bar; unsigned x; volatile LAS unsigned* st; };
__device__ __forceinline__ XcdBarrier xcd_barrier_post(unsigned* bar, volatile LAS unsigned* st) {
    XcdBarrier b; b.bar = bar; b.x = xb_xcc_id(); b.st = st;
    if (threadIdx.x == 0) (void)xb_add(&bar[XB_XCNT(b.x)], 1u);
    return b;
}
__device__ __forceinline__ void xcd_barrier_complete(unsigned* bar, unsigned x, unsigned& nloc, unsigned& nx) {
    const unsigned G = gridDim.x * gridDim.y * gridDim.z;
    unsigned sum, cnt, mine, sp = 0u;
    for (;;) {
        sum = 0u; cnt = 0u; mine = 0u;
#pragma unroll
        for (unsigned j = 0; j < 16; ++j) { const unsigned c = xb_ld(&bar[XB_XCNT(j)]); sum += c; cnt += (c > 0u) ? 1u : 0u; mine = (j == x) ? c : mine; }
        if (sum == G) break;
        __builtin_amdgcn_s_sleep(1);
        if ((++sp & 255u) == 0u) { if (xb_ld(&bar[XB_TMO])) break; if (sp > XB_SPIN_CAP) { atomicAdd(&bar[XB_TMO], 1u); break; } }
    }
    nloc = mine > 0u ? mine : 1u; nx = cnt > 0u ? cnt : 1u;
}
__device__ __forceinline__ void xcd_barrier(const XcdBarrier& b) {
    asm volatile("s_waitcnt vmcnt(0)" ::: "memory");
    __syncthreads();
    if (threadIdx.x == 0) {
        unsigned* bar = b.bar;
        __builtin_amdgcn_s_waitcnt(0);
        unsigned nloc = b.st[0], nx = b.st[1];
        if (nloc == 0u) { xcd_barrier_complete(bar, b.x, nloc, nx); b.st[0] = nloc; b.st[1] = nx; }
        const unsigned old = xb_add(&bar[XB_XSUB(b.x)], 1u);
        const unsigned gen = old / nloc;
        if (old + 1u == (gen + 1u) * nloc) {
            __builtin_amdgcn_fence(__ATOMIC_RELEASE, "agent");
            asm volatile("s_waitcnt vmcnt(0)" ::: "memory");
            const unsigned og = xb_add(&bar[XB_TOP], 1u);
            const unsigned tg = og / nx;
            if (og + 1u == (tg + 1u) * nx) xb_add(&bar[XB_TOPGEN], 1u);
            else XB_SPIN(xb_ld(&bar[XB_TOPGEN]) == tg, bar);
            __builtin_amdgcn_fence(__ATOMIC_ACQUIRE, "agent");
            xb_add(&bar[XB_XGEN(b.x)], 1u);
            asm volatile("s_waitcnt vmcnt(0)" ::: "memory");
        } else {
            XB_SPIN(xb_ld(&bar[XB_XGEN(b.x)]) == gen, bar);
            __builtin_amdgcn_fence(__ATOMIC_ACQUIRE, "agent");
            asm volatile("s_waitcnt vmcnt(0)" ::: "memory");
        }
    }
    __syncthreads();
}

#define SB_BASE(s) (4352 + 1088 * (s))
__device__ __forceinline__ void split_arrive(unsigned* ctl, volatile LAS unsigned* st, int s) {
    asm volatile("s_waitcnt vmcnt(0)" ::: "memory");
    __syncthreads();
    if (threadIdx.x == 0) {
        unsigned* bar = ctl + SB_BASE(s);
        const unsigned x = xb_xcc_id(), nloc = st[0];
        __builtin_amdgcn_s_waitcnt(0);
        const unsigned old = xb_add(&bar[64 * x], 1u);
        if (old + 1u == nloc) {
            __builtin_amdgcn_fence(__ATOMIC_RELEASE, "agent");
            asm volatile("s_waitcnt vmcnt(0)" ::: "memory");
            (void)xb_add(&bar[1024], 1u);
        }
    }
}
__device__ __forceinline__ void split_wait_wave(unsigned* ctl, unsigned nx, int s) {
    unsigned* bar = ctl + SB_BASE(s);
    XB_SPIN(xb_ld(&bar[1024]) < nx, ctl);
    __builtin_amdgcn_fence(__ATOMIC_ACQUIRE, "agent");
    asm volatile("s_waitcnt vmcnt(0)" ::: "memory");
}
constexpr int BM = 256, BK = 64, HALF = 128, HTB = HALF * BK * 2, NXCD = 8, WGM = 4;
__device__ __forceinline__ int lds_byte(int r, int c) { const int st = (r >> 4) * 2 + (c >> 5), rr = r & 15, cc = c & 31, ob = rr * 64 + cc * 2; return st * 1024 + (ob ^ (((ob >> 9) & 1) << 5)); }
__device__ __forceinline__ void stage_rc(int b, int& R, int& C) { const int st = b / 1024, sb = b % 1024, swz = sb ^ (((sb >> 9) & 1) << 5); R = (st >> 1) * 16 + swz / 64; C = (st & 1) * 32 + (swz % 64) / 2; }
__device__ __forceinline__ int perm32(int rho) { const int n = rho >> 4, i = rho & 15; return 8 * (i >> 2) + 4 * n + (i & 3); }

struct Unit { const char* A; const char* B; int pm, pn, kind, aux; };
struct TileOrder {
    int nM, nN, nwg;
    __device__ __forceinline__ void init(int M, int N) { nM = M / BM; nN = N / BM; nwg = nM * nN; }
    __device__ __forceinline__ bool get(long L, int& pm, int& pn) const {
        if (L >= nwg) return false;
        int wgid = (int)L; { const int q = nwg / NXCD, r = nwg % NXCD, xcd = wgid % NXCD, off = wgid / NXCD; wgid = (xcd < r ? xcd * (q + 1) : r * (q + 1) + (xcd - r) * q) + off; }
        const int nig = WGM * nN, gid = wgid / nig, fm = gid * WGM, gsz = (nM - fm) < WGM ? (nM - fm) : WGM;
        pm = fm + ((wgid % nig) % gsz); pn = (wgid % nig) / gsz; return true;
    }
};

template <class Epi, class Sched>
__device__ __forceinline__ void gemm_phase(LAS unsigned char* lds, const int K, const Sched& S, const Epi& E) {
    int tid = threadIdx.x; asm volatile("" : "+v"(tid));
    const int wid = __builtin_amdgcn_readfirstlane(tid >> 6), lane = tid & 63, wr = wid >> 2, wc = wid & 3, fr = lane & 15, fq = lane >> 4;
    const int nt = K / BK;
    int sR[2], sC[2]; unsigned voffB[2];
#pragma unroll
    for (int i = 0; i < 2; ++i) { stage_rc(tid * 16 + i * 8192, sR[i], sC[i]); const int Rb = (sR[i] & ~31) + perm32(sR[i] & 31); voffB[i] = (unsigned)(Rb * K + sC[i]) * 2u; }
    const size_t kstep = (size_t)(BK * 2);
    const size_t hstep = (size_t)HALF * K * 2;
    const unsigned ldsw = (unsigned)wid * 1024u;
    const int aoff = lds_byte(wr * 64 + fr, fq * 8), boff = lds_byte(wc * 32 + fr, fq * 8);
#define PG8_SA(b, h) (((b) * 2 + (h)) * HTB)
#define PG8_SB(b, h) ((4 + (b) * 2 + (h)) * HTB)
#define PG8_STAGE(bufoff, gbase, voff) do { _Pragma("unroll") for (int _i = 0; _i < 2; ++_i) \
        __builtin_amdgcn_global_load_lds((const unsigned*)((const char*)(gbase) + (voff)[_i]), (LAS unsigned*)(lds + (bufoff) + ldsw + _i * 8192), 16, 0, 0); } while (0)
#define PG8_LDA(dst, b, h) do { _Pragma("unroll") for (int m = 0; m < 4; ++m) _Pragma("unroll") for (int k = 0; k < 2; ++k) dst[m][k] = *(const LAS bf16x8*)(lds + PG8_SA(b, h) + aoff + m * 2048 + k * 1024); } while (0)
#define PG8_LDB(dst, b, h) do { _Pragma("unroll") for (int n = 0; n < 2; ++n) _Pragma("unroll") for (int k = 0; k < 2; ++k) dst[n][k] = *(const LAS bf16x8*)(lds + PG8_SB(b, h) + boff + n * 2048 + k * 1024); } while (0)
#define PG8_MMA(ai, bj, At, Bt) do { __builtin_amdgcn_s_setprio(1); _Pragma("unroll") for (int m = 0; m < 4; ++m) _Pragma("unroll") for (int n = 0; n < 2; ++n) _Pragma("unroll") for (int k = 0; k < 2; ++k) \
        acc[ai][bj][m][n] = __builtin_amdgcn_mfma_f32_16x16x32_bf16(Bt[n][k], At[m][k], acc[ai][bj][m][n], 0, 0, 0); __builtin_amdgcn_s_setprio(0); } while (0)
#define PG8_WAIT_V(n) asm volatile("s_waitcnt vmcnt(" #n ")" ::: "memory")
#define PG8_WAIT_L(n) asm volatile("s_waitcnt lgkmcnt(" #n ")" ::: "memory")
#define PG8_BAR __builtin_amdgcn_s_barrier()
#define PG8_SCHED __builtin_amdgcn_sched_barrier(0)
    Unit cur, nxt; int ui = 0;
    if (!S.next(0, cur)) return;
    f32x4 acc[2][2][4][2];
#pragma unroll
    for (int a = 0; a < 2; ++a)
#pragma unroll
        for (int b = 0; b < 2; ++b)
#pragma unroll
            for (int m = 0; m < 4; ++m)
#pragma unroll
                for (int n = 0; n < 2; ++n) acc[a][b][m][n] = (f32x4){0.f, 0.f, 0.f, 0.f};
    bf16x8 At[4][2], B0[2][2], B1[2][2];
    unsigned voffA[2];
#pragma unroll
    for (int i = 0; i < 2; ++i) voffA[i] = (unsigned)(sR[i] * K + sC[i]) * 2u;
    LAS int* tokb = (LAS int*)(lds + LDS_MISC + 4096);
#define PG8_GETOFF(dst, par, half) do { if constexpr (Sched::GATHER) { _Pragma("unroll") for (int _i = 0; _i < 2; ++_i) { const int _t = tokb[(par) * 256 + (half) * 128 + sR[_i]]; dst[_i] = (unsigned)(_t * K + sC[_i]) * 2u; } } \
        else { dst[0] = voffA[0]; dst[1] = voffA[1]; } } while (0)
    if constexpr (Sched::GATHER) { if (tid < 256) tokb[tid] = S.row_id(cur, tid); PG8_WAIT_L(0); PG8_BAR; }
    const char* cA0 = cur.A; const char* cA1 = cur.A + (Sched::GATHER ? (size_t)0 : hstep); const char* cB = cur.B;
    { unsigned o0[2], o1[2]; PG8_GETOFF(o0, 0, 0); PG8_GETOFF(o1, 0, 1);
    PG8_STAGE(PG8_SB(0, 0), cB, voffB); PG8_STAGE(PG8_SB(0, 1), cB + hstep, voffB); PG8_STAGE(PG8_SA(0, 0), cA0, o0); PG8_STAGE(PG8_SA(0, 1), cA1, o1);
    if (wr == 1) PG8_BAR;
    PG8_WAIT_V(2); PG8_BAR;
    PG8_STAGE(PG8_SB(1, 0), cB + kstep, voffB); PG8_STAGE(PG8_SA(1, 0), cA0 + kstep, o0); PG8_STAGE(PG8_SB(1, 1), cB + hstep + kstep, voffB);
    PG8_WAIT_V(6); PG8_BAR; }
    for (;;) {
        const bool has_next = S.next(ui + 1, nxt);
        const char* nA0 = cA0; const char* nA1 = cA1; const char* nB = cB;
        const int par = ui & 1;
        if (has_next) { nA0 = nxt.A; nA1 = nxt.A + (Sched::GATHER ? (size_t)0 : hstep); nB = nxt.B;
            if constexpr (Sched::GATHER) { if (tid < 256) tokb[(par ^ 1) * 256 + tid] = S.row_id(nxt, tid); } }
        for (int t = 0; t < nt; t += 2) {
            const bool last = (t == nt - 2);
            const char* a1_1 = cA1 + (size_t)(t + 1) * kstep;
            const char* a2_0 = last ? nA0 : cA0 + (size_t)(t + 2) * kstep; const char* a2_1 = last ? nA1 : cA1 + (size_t)(t + 2) * kstep; const char* b2 = last ? nB : cB + (size_t)(t + 2) * kstep;
            const char* a3_0 = a2_0 + kstep; const char* b3 = b2 + kstep;
            unsigned cO1[2], o2_0[2], o2_1[2];
            const int p2 = (last && has_next) ? (par ^ 1) : par;
            PG8_GETOFF(cO1, par, 1); PG8_GETOFF(o2_0, p2, 0); PG8_GETOFF(o2_1, p2, 1);
            PG8_LDB(B0, 0, 0); PG8_LDB(B1, 0, 1); PG8_SCHED; PG8_LDA(At, 0, 0); PG8_STAGE(PG8_SA(1, 1), a1_1, cO1);
            PG8_WAIT_V(8); PG8_WAIT_L(0); PG8_BAR; PG8_MMA(0, 0, At, B0); PG8_MMA(0, 1, At, B1); PG8_BAR; PG8_SCHED;
            PG8_LDA(At, 0, 1); PG8_STAGE(PG8_SB(0, 0), b2, voffB); PG8_STAGE(PG8_SB(0, 1), b2 + hstep, voffB); PG8_STAGE(PG8_SA(0, 0), a2_0, o2_0);
            PG8_WAIT_V(8); PG8_WAIT_L(0); PG8_BAR; PG8_MMA(1, 0, At, B0); PG8_MMA(1, 1, At, B1); PG8_BAR; PG8_SCHED;
            PG8_LDB(B0, 1, 0); PG8_LDB(B1, 1, 1); PG8_SCHED; PG8_LDA(At, 1, 0); PG8_STAGE(PG8_SA(0, 1), a2_1, o2_1);
            PG8_WAIT_V(8); PG8_WAIT_L(0); PG8_BAR; PG8_MMA(0, 0, At, B0); PG8_MMA(0, 1, At, B1); PG8_BAR; PG8_SCHED;
            PG8_LDA(At, 1, 1); PG8_STAGE(PG8_SB(1, 0), b3, voffB); PG8_STAGE(PG8_SB(1, 1), b3 + hstep, voffB); PG8_STAGE(PG8_SA(1, 0), a3_0, o2_0);
            PG8_WAIT_V(8); PG8_WAIT_L(0); PG8_BAR; PG8_MMA(1, 0, At, B0); PG8_MMA(1, 1, At, B1); PG8_BAR; PG8_SCHED;
        }
        if (wr == 0) PG8_BAR;
        E(acc, cur, wr, wc, fr, fq);
        if (!has_next) break;
#pragma unroll
        for (int a = 0; a < 2; ++a)
#pragma unroll
            for (int b = 0; b < 2; ++b)
#pragma unroll
                for (int m = 0; m < 4; ++m)
#pragma unroll
                    for (int n = 0; n < 2; ++n) acc[a][b][m][n] = (f32x4){0.f, 0.f, 0.f, 0.f};
        cur = nxt; cA0 = nA0; cA1 = nA1; cB = nB; ++ui;
        if (wr == 1) PG8_BAR;
    }
    PG8_WAIT_V(0);
    PG8_BAR;
#undef PG8_SA
#undef PG8_GETOFF
#undef PG8_SB
#undef PG8_STAGE
#undef PG8_LDA
#undef PG8_LDB
#undef PG8_MMA
#undef PG8_WAIT_V
#undef PG8_WAIT_L
#undef PG8_BAR
#undef PG8_SCHED
}

struct Params {
    const float* x; const int* pos; const float* w_in; const float* lb_logits; const float* hg_norm_g; const float* ret_norm_g;
    const float* w_bh; const float* w_br; const float* w_out; const float* ln1_g; const float* ln1_b;
    const float* w_group; const float* b_group; const float* w_router; const float* b_router;
    const float* w1; const float* w3; const float* w2; const float* ln2_g; const float* ln2_b;
    float* out; unsigned char* ws;
};

enum { ACT_NONE = 0, ACT_SILU = 1, ACT_LOGF = 2, ACT_ROTQ = 3, ACT_ROTK = 4, ACT_SIG = 5 };
struct StaticSchedBase {
    static constexpr bool GATHER = false;
    __device__ __forceinline__ int row_id(const Unit&, int) const { return 0; }
};
constexpr int NHR = 896;
constexpr int NGA_H = NHR - (512 - 4 * RG2_PANELS);
struct SchedProj : StaticSchedBase {
    TileOrder to; const char* A; const char* Bt; int col0; unsigned kinds; int G, c;
    __device__ __forceinline__ bool next(int i, Unit& u) const {
        int pm, pn; if (!to.get((long)i * G + c, pm, pn)) return false;
        u.pm = pm; u.pn = pn; u.A = A + (size_t)pm * 256 * 2048; u.B = Bt + (size_t)(col0 + pn * 256) * 2048;
        u.aux = pn >> 2; u.kind = (int)((kinds >> (4 * (pn >> 2))) & 15u); return true;
    }
};
struct SchedMix : StaticSchedBase {
    TileOrder to; const char* xb; const char* ohg; const char* oret; const char* win; const char* wbh; const char* wbr; int G, c; unsigned* ctl; unsigned nx;
    __device__ __forceinline__ bool next(int i, Unit& u) const {
        const int nT = (c < 512) ? (512 - c + G - 1) / G : 0;
        if (i >= 2 * nT) return false;
        if (i == nT) split_wait_wave(ctl, nx, 0);
        int pm, pn; const int k = (i < nT) ? 1 : 3; const long L = (long)c + (long)((i < nT) ? i : i - nT) * G;
        to.get(L, pm, pn);
        u.pm = pm; u.pn = pn; u.kind = k; u.aux = 0;
        const size_t ao = (size_t)pm * 256 * 2048, bo = (size_t)pn * 256 * 2048;
        if (k == 0)      { u.A = xb + ao;   u.B = win + (size_t)9216 * 2048 + bo; }
        else if (k == 1) { u.A = xb + ao;   u.B = win + (size_t)10240 * 2048 + bo; }
        else if (k == 2) { u.A = ohg + ao;  u.B = wbh + bo; }
        else             { u.A = oret + ao; u.B = wbr + bo; }
        return true;
    }
};
struct SchedGates2 : StaticSchedBase {
    TileOrder to; const char* A; const char* Bt; int G, c;
    __device__ __forceinline__ bool next(int i, Unit& u) const {
        const long L = (long)i * G + c; if (L >= 1024) return false;
        int pm, pn; const bool isg = L >= 512;
        to.get(isg ? L - 512 : L, pm, pn);
        u.B = Bt + (size_t)((isg ? 9216 : 4096) + pn * 256) * 2048; u.aux = isg ? 7 : 4;
        u.pm = pm; u.pn = pn; u.A = A + (size_t)pm * 256 * 2048; u.kind = isg ? ACT_SIG : ACT_SILU; return true;
    }
};
struct SchedProjR : StaticSchedBase {
    TileOrder to; const char* A; const char* Bt; int G, c;
    __device__ __forceinline__ bool next(int i, Unit& u) const {
        const long L = (long)i * G + c; if (L >= 1536) return false;
        int pm, pn; to.get(L, pm, pn); u.pm = pm; u.pn = pn; u.A = A + (size_t)pm * 256 * 2048; u.B = Bt + (size_t)(5120 + pn * 256) * 2048;
        u.aux = pn >> 2; u.kind = (pn >> 2) == 0 ? ACT_ROTQ : ((pn >> 2) == 1 ? ACT_ROTK : ACT_NONE); return true;
    }
};
struct SchedRetHelp : StaticSchedBase {
    TileOrder to; const char* A; const char* Bt; const char* ohg; const char* wbh; int G, c;
    __device__ __forceinline__ bool next(int i, Unit& u) const {
        const long L = (long)i * G + c; if (L >= 1024) return false;
        const bool isp = L >= 512; int pm, pn;
        to.get(isp ? L - 512 : L, pm, pn);
        u.pm = pm; u.pn = pn;
        if (isp) { u.A = ohg + (size_t)pm * 256 * 2048; u.B = wbh + (size_t)pn * 256 * 2048; u.aux = 8; u.kind = 2; }
        else { u.A = A + (size_t)pm * 256 * 2048; u.B = Bt + (size_t)(8192 + pn * 256) * 2048; u.aux = 5; u.kind = ACT_SILU; }
        return true;
    }
};
struct SchedPlain : StaticSchedBase {
    TileOrder to; const char* A; const char* Bt; int G, c; int K;
    __device__ __forceinline__ bool next(int i, Unit& u) const {
        int pm, pn; if (!to.get((long)i * G + c, pm, pn)) return false;
        u.pm = pm; u.pn = pn; u.kind = 0; u.aux = 0; u.A = A + (size_t)pm * 256 * K * 2; u.B = Bt + (size_t)pn * 256 * K * 2; return true;
    }
};
struct SchedMoe {
    const LAS int* tab; int G, c; int NU, per;
    const char* Abase; const char* Bbase; size_t b_estride; int K; bool gather;
    const int* lent;
    __device__ __forceinline__ void init_counts() { NU = tab[64] * 4; per = (NU + 7) / 8; }
    __device__ __forceinline__ bool decode(int i, int& e, int& mt, int& nt) const {
        const long L = (long)i * G + c; const int x = (int)(L % 8); const long j = L / 8;
        if (j >= per) return false; const long idx = (long)x * per + j; if (idx >= NU) return false;
        int ee = 0;
#pragma unroll 1
        for (int q = 1; q < 32; ++q) { if (4 * tab[32 + q] <= idx) ee = q; }
        e = ee; const int tiles = (tab[e] + 255) >> 8; const int r = (int)(idx - 4 * tab[32 + e]);
        nt = r / tiles; mt = r % tiles; return true;
    }
};
struct SchedMoe1 : SchedMoe {
    static constexpr bool GATHER = true;
    __device__ __forceinline__ bool next(int i, Unit& u) const {
        int e, mt, nt; if (!decode(i, e, mt, nt)) return false;
        u.pm = tab[32 + e] + mt; u.pn = nt; u.aux = e; u.kind = mt; u.A = Abase; u.B = Bbase + (size_t)e * b_estride + (size_t)nt * 256 * K * 2; return true;
    }
    __device__ __forceinline__ int row_id(const Unit& u, int r) const {
        const int cnt = tab[u.aux]; const int pp = u.kind * 256 + r;
        return (pp < cnt) ? (lent[(size_t)u.aux * LCAP + pp] >> 1) : 0;
    }
};
struct SchedMoe2 : SchedMoe {
    static constexpr bool GATHER = false;
    __device__ __forceinline__ bool next(int i, Unit& u) const {
        int e, mt, nt; if (!decode(i, e, mt, nt)) return false;
        u.pm = tab[32 + e] + mt; u.pn = nt; u.aux = e; u.kind = mt; u.A = Abase + (size_t)u.pm * 256 * K * 2; u.B = Bbase + (size_t)e * b_estride + (size_t)nt * 256 * K * 2; return true;
    }
    __device__ __forceinline__ int row_id(const Unit&, int) const { return 0; }
};

#define EPI_ROWLOOP for (int ai = 0; ai < 2; ++ai) for (int m = 0; m < 4; ++m)
struct EpiProj {
    bf16_t* U0; bf16_t* dgate; const float* lb; const int* pos; const double* inv2pi; bf16_t* dgate2; bf16_t* dgate3; bf16_t* dgate4;
    __device__ __forceinline__ void operator()(const f32x4 (&acc)[2][2][4][2], const Unit& u, int wr, int wc, int fr, int fq) const {
        bf16_t* dst = (u.aux < 4) ? U0 + (size_t)u.aux * (USTR / 2) : (u.aux == 4 ? dgate : (u.aux == 5 ? dgate2 : (u.aux == 6 ? dgate3 : dgate4)));
        const int kind = u.kind;
        const int cg0 = (u.pn & 3) * 256 + wc * 32 + 8 * fq;
        const int row0 = u.pm * 256 + wr * 64 + fr;
        if (kind == ACT_ROTQ || kind == ACT_ROTK) {
            const float sc = (kind == ACT_ROTK) ? 0.0625f : 1.0f;
            float ivh[2][4], ivl[2][4];
#pragma unroll
            for (int bj = 0; bj < 2; ++bj)
#pragma unroll
                for (int j = 0; j < 4; ++j) { const int pi = (bj * 128 + wc * 32 + 8 * fq) / 2 + j; ivh[bj][j] = ((const float*)inv2pi)[2 * pi]; ivl[bj][j] = ((const float*)inv2pi)[2 * pi + 1]; }
            int posv[2][4];
#pragma unroll
            for (int ai = 0; ai < 2; ++ai)
#pragma unroll
                for (int m = 0; m < 4; ++m) posv[ai][m] = pos[row0 + ai * 128 + m * 16];
#pragma unroll
            for (int ai = 0; ai < 2; ++ai)
#pragma unroll
                for (int m = 0; m < 4; ++m) {
                    const int row = row0 + ai * 128 + m * 16; const float pf = (float)posv[ai][m];
#pragma unroll
                    for (int bj = 0; bj < 2; ++bj) {
                        const f32x4 v0 = acc[ai][bj][m][0], v1 = acc[ai][bj][m][1];
                        float o[8]; const float in[8] = {v0[0], v0[1], v0[2], v0[3], v1[0], v1[1], v1[2], v1[3]};
#pragma unroll
                        for (int j = 0; j < 4; ++j) {
                            const float r = __builtin_amdgcn_fractf(__builtin_amdgcn_fractf(pf * ivh[bj][j]) + __builtin_amdgcn_fractf(pf * ivl[bj][j]));
                            const float sn = __builtin_amdgcn_sinf(r), cs = __builtin_amdgcn_cosf(r);
                            const float t1 = in[2 * j], t2 = in[2 * j + 1];
                            o[2 * j] = (t1 * cs - t2 * sn) * sc; o[2 * j + 1] = (t1 * sn + t2 * cs) * sc;
                        }
                        u32x4 w; w.x = pk2(o[0], o[1]); w.y = pk2(o[2], o[3]); w.z = pk2(o[4], o[5]); w.w = pk2(o[6], o[7]);
                        {
                            const int t = row & 63, d0 = bj * 128 + wc * 32 + 8 * fq; const int f = 8 * (t >> 4) + (d0 >> 5), L = (t & 15) + 16 * ((d0 >> 3) & 3);
                            *(u32x4*)(dst + (size_t)(row - t + 2 * f + (L >> 5)) * DM + (u.pn & 3) * 256 + (L & 31) * 8) = w; }
                    }
                }
            return;
        }
        f32x4 lb0[2], lb1[2];
#pragma unroll
        for (int bj = 0; bj < 2; ++bj) { lb0[bj] = (f32x4){0.f, 0.f, 0.f, 0.f}; lb1[bj] = lb0[bj]; }
        if (kind == ACT_LOGF) {
#pragma unroll
            for (int bj = 0; bj < 2; ++bj) { lb0[bj] = *(const f32x4*)(lb + cg0 + bj * 128); lb1[bj] = *(const f32x4*)(lb + cg0 + bj * 128 + 4); }
        }
#pragma unroll
        for (int ai = 0; ai < 2; ++ai)
#pragma unroll
            for (int m = 0; m < 4; ++m) {
                const int row = row0 + ai * 128 + m * 16;
#pragma unroll
                for (int bj = 0; bj < 2; ++bj) {
                    f32x4 v0 = acc[ai][bj][m][0], v1 = acc[ai][bj][m][1];
                    if (kind == ACT_SILU) {
#pragma unroll
                        for (int j = 0; j < 4; ++j) { v0[j] = siluf_(v0[j]); v1[j] = siluf_(v1[j]); }
                    } else if (kind == ACT_SIG) {
#pragma unroll
                        for (int j = 0; j < 4; ++j) { v0[j] = sigmoidf_(v0[j]); v1[j] = sigmoidf_(v1[j]); }
                    } else if (kind == ACT_LOGF) {
#pragma unroll
                        for (int j = 0; j < 4; ++j) { v0[j] = __log2f(lb0[bj][j] + (1.f - lb0[bj][j]) * sigmoidf_(v0[j])); v1[j] = __log2f(lb1[bj][j] + (1.f - lb1[bj][j]) * sigmoidf_(v1[j])); }
                    }
                    u32x4 w; w.x = pk2(v0[0], v0[1]); w.y = pk2(v0[2], v0[3]); w.z = pk2(v1[0], v1[1]); w.w = pk2(v1[2], v1[3]);
                    *(u32x4*)(dst + (size_t)row * DM + cg0 + bj * 128) = w;
                }
            }
    }
};
struct EpiMix {
    bf16_t* ga; bf16_t* gb; bf16_t* part; bf16_t* merged;
    __device__ __forceinline__ void operator()(const f32x4 (&acc)[2][2][4][2], const Unit& u, int wr, int wc, int fr, int fq) const {
        const int kind = u.kind;
        const int c0 = u.pn * 256 + wc * 32 + 8 * fq; const int row0 = u.pm * 256 + wr * 64 + fr;
        if (kind < 2) {
            bf16_t* dst = (kind == 0) ? ga : gb;
#pragma unroll
            for (int ai = 0; ai < 2; ++ai)
#pragma unroll
                for (int m = 0; m < 4; ++m)
#pragma unroll
                    for (int bj = 0; bj < 2; ++bj) {
                        f32x4 v0 = acc[ai][bj][m][0], v1 = acc[ai][bj][m][1];
#pragma unroll
                        for (int j = 0; j < 4; ++j) { v0[j] = sigmoidf_(v0[j]); v1[j] = sigmoidf_(v1[j]); }
                        u32x4 w; w.x = pk2(v0[0], v0[1]); w.y = pk2(v0[2], v0[3]); w.z = pk2(v1[0], v1[1]); w.w = pk2(v1[2], v1[3]);
                        *(u32x4*)(dst + (size_t)(row0 + ai * 128 + m * 16) * DM + c0 + bj * 128) = w;
                    }
            return;
        }
        const bf16_t* gp = (kind == 2) ? ga : gb;
#pragma unroll
        for (int ai = 0; ai < 2; ++ai) {
            u32x4 g[4][2], pw[4][2];
#pragma unroll
            for (int m = 0; m < 4; ++m)
#pragma unroll
                for (int bj = 0; bj < 2; ++bj) { const size_t o = (size_t)(row0 + ai * 128 + m * 16) * DM + c0 + bj * 128;
                    g[m][bj] = *(const u32x4*)(gp + o); pw[m][bj] = (kind == 3) ? *(const u32x4*)(part + o) : (u32x4){0u, 0u, 0u, 0u}; }
#pragma unroll
            for (int m = 0; m < 4; ++m)
#pragma unroll
                for (int bj = 0; bj < 2; ++bj) { const size_t o = (size_t)(row0 + ai * 128 + m * 16) * DM + c0 + bj * 128;
                    f32x4 v0 = acc[ai][bj][m][0], v1 = acc[ai][bj][m][1]; const u32x4 gg = g[m][bj], pp = pw[m][bj];
                    v0[0] = v0[0] * bflo(gg.x) + bflo(pp.x); v0[1] = v0[1] * bfhi(gg.x) + bfhi(pp.x); v0[2] = v0[2] * bflo(gg.y) + bflo(pp.y); v0[3] = v0[3] * bfhi(gg.y) + bfhi(pp.y);
                    v1[0] = v1[0] * bflo(gg.z) + bflo(pp.z); v1[1] = v1[1] * bfhi(gg.z) + bfhi(pp.z); v1[2] = v1[2] * bflo(gg.w) + bflo(pp.w); v1[3] = v1[3] * bfhi(gg.w) + bfhi(pp.w);
                    u32x4 w; w.x = pk2(v0[0], v0[1]); w.y = pk2(v0[2], v0[3]); w.z = pk2(v1[0], v1[1]); w.w = pk2(v1[2], v1[3]);
                    *(u32x4*)(((kind == 2) ? part : merged) + o) = w; }
        }
    }
};
struct EpiRetHelp {
    EpiProj P; EpiMix M;
    __device__ __forceinline__ void operator()(const f32x4 (&acc)[2][2][4][2], const Unit& u, int wr, int wc, int fr, int fq) const {
        if (u.aux == 8) M(acc, u, wr, wc, fr, fq); else P(acc, u, wr, wc, fr, fq);
    }
};
struct EpiPre1 {
    const float* x; float* out;
    __device__ __forceinline__ void operator()(const f32x4 (&acc)[2][2][4][2], const Unit& u, int wr, int wc, int fr, int fq) const {
        const int c0 = u.pn * 256 + wc * 32 + 8 * fq; const int row0 = u.pm * 256 + wr * 64 + fr;
#pragma unroll
        for (int ai = 0; ai < 2; ++ai)
#pragma unroll
            for (int mh = 0; mh < 2; ++mh) {
                f32x4 xv[2][2][2];
#pragma unroll
                for (int m2 = 0; m2 < 2; ++m2)
#pragma unroll
                    for (int bj = 0; bj < 2; ++bj) { const size_t o = (size_t)(row0 + ai * 128 + (2 * mh + m2) * 16) * DM + c0 + bj * 128;
                        xv[m2][bj][0] = *(const f32x4*)(x + o); xv[m2][bj][1] = *(const f32x4*)(x + o + 4); }
#pragma unroll
                for (int m2 = 0; m2 < 2; ++m2)
#pragma unroll
                    for (int bj = 0; bj < 2; ++bj) { const size_t o = (size_t)(row0 + ai * 128 + (2 * mh + m2) * 16) * DM + c0 + bj * 128;
                        *(f32x4*)(out + o) = xv[m2][bj][0] * ALPHA + acc[ai][bj][2 * mh + m2][0]; *(f32x4*)(out + o + 4) = xv[m2][bj][1] * ALPHA + acc[ai][bj][2 * mh + m2][1]; }
            }
    }
};
struct EpiMoe1 {
    bf16_t* H;
    __device__ __forceinline__ void operator()(const f32x4 (&acc)[2][2][4][2], const Unit& u, int wr, int wc, int fr, int fq) const {
        const int hc0 = (u.pn * 256 + wc * 32 + 8 * fq) >> 1; const int row0 = u.pm * 256 + wr * 64 + fr;
#pragma unroll
        for (int ai = 0; ai < 2; ++ai)
#pragma unroll
            for (int m = 0; m < 4; ++m) {
                const size_t ro = (size_t)(row0 + ai * 128 + m * 16) * 512 + hc0;
#pragma unroll
                for (int bj = 0; bj < 2; ++bj) {
                    const f32x4 v0 = acc[ai][bj][m][0], v1 = acc[ai][bj][m][1];
                    u32x2 w; w.x = pk2(siluf_(v0[0]) * v0[1], siluf_(v0[2]) * v0[3]); w.y = pk2(siluf_(v1[0]) * v1[1], siluf_(v1[2]) * v1[3]);
                    *(u32x2*)(H + ro + bj * 64) = w;
                }
            }
    }
};
struct EpiMoe2 {
    bf16_t* Y0; long ydelta; const int* lent; const float* lw; const LAS int* tab;
    __device__ __forceinline__ void operator()(const f32x4 (&acc)[2][2][4][2], const Unit& u, int wr, int wc, int fr, int fq) const {
        const int c0 = u.pn * 256 + wc * 32 + 8 * fq; const int e = u.aux, cnt = tab[e];
        const int* le = lent + (size_t)e * LCAP; const float* lwp = lw + (size_t)e * LCAP;
        int ents[2][4]; float wts[2][4];
#pragma unroll
        for (int ai = 0; ai < 2; ++ai)
#pragma unroll
            for (int m = 0; m < 4; ++m) { const int p = u.kind * 256 + ai * 128 + wr * 64 + m * 16 + fr; const bool ok = p < cnt; ents[ai][m] = ok ? le[p] : 0; wts[ai][m] = ok ? lwp[p] : 0.f; }
#pragma unroll
        for (int ai = 0; ai < 2; ++ai)
#pragma unroll
            for (int m = 0; m < 4; ++m) {
                const int p = u.kind * 256 + ai * 128 + wr * 64 + m * 16 + fr;
                if (p < cnt) {
                    const int ent = ents[ai][m]; const float w = wts[ai][m];
                    bf16_t* yb = Y0 + (long)(ent & 1) * ydelta + (size_t)(ent >> 1) * DM + c0;
#pragma unroll
                    for (int bj = 0; bj < 2; ++bj) {
                        const f32x4 v0 = acc[ai][bj][m][0] * w, v1 = acc[ai][bj][m][1] * w;
                        u32x4 o; o.x = pk2(v0[0], v0[1]); o.y = pk2(v0[2], v0[3]); o.z = pk2(v1[0], v1[1]); o.w = pk2(v1[2], v1[3]);
                        *(u32x4*)(yb + bj * 128) = o;
                    }
                }
            }
    }
};

__device__ __forceinline__ void transpose_item(const float* W, int K, int N, bf16_t* WT, int row_off, int rmul, int radd, LAS float* scr, int item, int lane) {
    const int nblk = N / 32, kb = item / nblk, nb = item % nblk, k0 = 64 * kb, n0 = 32 * nb;
#pragma unroll 8
    for (int i = 0; i < 32; ++i) { const int kk = 2 * i + (lane >> 5); scr[kk * 33 + (lane & 31)] = W[(size_t)(k0 + kk) * N + n0 + (lane & 31)]; }
    asm volatile("s_waitcnt lgkmcnt(0)" ::: "memory");
    const int c = lane & 7;
#pragma unroll
    for (int j = 0; j < 4; ++j) { const int n = (lane >> 3) + 8 * j; const LAS float* s = scr + (8 * c) * 33 + n;
        u32x4 o; o.x = pk2(s[0 * 33], s[1 * 33]); o.y = pk2(s[2 * 33], s[3 * 33]); o.z = pk2(s[4 * 33], s[5 * 33]); o.w = pk2(s[6 * 33], s[7 * 33]);
        *(u32x4*)(WT + (size_t)(row_off + (n0 + n) * rmul + radd) * K + k0 + 8 * c) = o; }
    asm volatile("s_waitcnt lgkmcnt(0)" ::: "memory");
}
__device__ __forceinline__ void p0_prep(const Params& p, LAS unsigned char* lds) {
    int tid = threadIdx.x; asm volatile("" : "+v"(tid));
    const int lane = tid & 63, wave = tid >> 6;
    const int gw = blockIdx.x * 8 + wave, NGW = gridDim.x * 8;
    LAS float* scr = (LAS float*)(lds + wave * 16384);
    bf16_t* WIN = (bf16_t*)(p.ws + OFF_WIN);
    constexpr int I_IN = 16 * (11264 / 32), I_SQ = 16 * 32;
    for (int it = gw; it < I_IN + 3 * I_SQ; it += NGW) {
        int r = it;
        if (r < I_IN) { transpose_item(p.w_in, 1024, 11264, WIN, 0, 1, 0, scr, r, lane); continue; } r -= I_IN;
        if (r < I_SQ) { transpose_item(p.w_bh, 1024, 1024, (bf16_t*)(p.ws + OFF_WBH), 0, 1, 0, scr, r, lane); continue; } r -= I_SQ;
        if (r < I_SQ) { transpose_item(p.w_br, 1024, 1024, (bf16_t*)(p.ws + OFF_WBR), 0, 1, 0, scr, r, lane); continue; } r -= I_SQ;
        transpose_item(p.w_out, 1024, 1024, (bf16_t*)(p.ws + OFF_WO), 0, 1, 0, scr, r, lane);
    }
    const size_t gt = (size_t)blockIdx.x * 512 + tid, gs = (size_t)gridDim.x * 512;
    u32x4* xb = (u32x4*)(p.ws + OFF_XB); const f32x4* x4 = (const f32x4*)p.x;
    for (size_t i = gt; i < TD / 8; i += gs) { const f32x4 a = x4[2 * i], b = x4[2 * i + 1]; u32x4 o; o.x = pk2(a[0], a[1]); o.y = pk2(a[2], a[3]); o.z = pk2(b[0], b[1]); o.w = pk2(b[2], b[3]); xb[i] = o; }
    float* lb = (float*)(p.ws + OFF_LB); double* inv = (double*)(p.ws + OFF_INV); float* wrt = (float*)(p.ws + OFF_WRT);
    for (size_t i = gt; i < 1024; i += gs) lb[i] = 1.0f / (1.0f + expf(p.lb_logits[i] - p.lb_logits[1024 + i]));
    for (size_t i = gt; i < 128; i += gs) { const double v = exp(-9.210340371976184 * (double)i / 127.0) * 0.15915494309189535;
        const float hi = __uint_as_float(__float_as_uint((float)v) & 0xffffc000u);
        ((float*)inv)[2 * i] = hi; ((float*)inv)[2 * i + 1] = (float)(v - (double)hi); }
    for (size_t i = gt; i < 36 * 1024; i += gs) { const int j = (int)(i >> 10), k = (int)(i & 1023); wrt[i] = (j < 4) ? p.w_group[k * 4 + j] : p.w_router[k * 32 + (j - 4)]; }
}

constexpr int QK_STR = 272, VT_STR = 144;
constexpr int L_QF = 0, L_KF = 17408, L_QB = 34816, L_KB = 52224, L_VT = 69632, L_A = 88064, L_SEGF = 97280, L_SEGB = 101376;
__device__ __forceinline__ float clamp80(float x) { return fminf(fmaxf(x, -115.f), 115.f); }
__device__ __forceinline__ void hgrn_p2a(bf16_t* Uq, bf16_t* Ulf, bf16_t* Ulb, bf16_t* Uv, bf16_t* Uqb, bf16_t* Uo, float* af, float* ab, LAS unsigned char* lds) {
    int tid = threadIdx.x; asm volatile("" : "+v"(tid));
    const int lane = tid & 63, seg = __builtin_amdgcn_readfirstlane(tid >> 6), dp = lane, l15 = lane & 15, kg = lane >> 4;
    LAS float* SEGF = (LAS float*)(lds + L_SEGF); LAS float* SEGB = (LAS float*)(lds + L_SEGB);
    unsigned wq[8], wv[8], wf[8], wb[8];
#define HA_LOAD(tk) do { const int h_ = (tk) & 7, n_ = ((tk) >> 3) & 127, b_ = (tk) >> 10; const size_t R0_ = (size_t)b_ * SEQ + 64 * n_; \
        _Pragma("unroll") for (int i = 0; i < 8; ++i) { const size_t g = (R0_ + 8 * seg + i) * DM + h_ * 128 + 2 * dp; \
            wq[i] = *(const unsigned*)(Uq + g); wf[i] = *(const unsigned*)(Ulf + g); wb[i] = *(const unsigned*)(Ulb + g); wv[i] = *(const unsigned*)(Uv + g); } } while (0)
    if ((int)blockIdx.x < 4 * 128 * 8) HA_LOAD((int)blockIdx.x);
    for (int task = blockIdx.x; task < 4 * 128 * 8; task += gridDim.x) {
        const int h = task & 7, n = (task >> 3) & 127, b = task >> 10;
        const size_t R0 = (size_t)b * SEQ + 64 * n;
        float pf0[8], pf1[8], sb0[8], sb1[8];
        { float r0 = 0.f, r1 = 0.f;
#pragma unroll
          for (int i = 0; i < 8; ++i) { r0 += bflo(wf[i]); r1 += bfhi(wf[i]); pf0[i] = r0; pf1[i] = r1; }
          r0 = 0.f; r1 = 0.f;
#pragma unroll
          for (int i = 7; i >= 0; --i) { r0 += bflo(wb[i]); r1 += bfhi(wb[i]); sb0[i] = r0; sb1[i] = r1; } }
        SEGF[seg * 128 + 2 * dp] = pf0[7]; SEGF[seg * 128 + 2 * dp + 1] = pf1[7]; SEGB[seg * 128 + 2 * dp] = sb0[0]; SEGB[seg * 128 + 2 * dp + 1] = sb1[0];
        asm volatile("s_waitcnt vmcnt(0)" ::: "memory");
        __syncthreads();
        float offf0 = 0.f, offf1 = 0.f, mf0 = 0.f, mf1 = 0.f, totf0 = 0.f, totf1 = 0.f, offb0 = 0.f, offb1 = 0.f, mb0 = 0.f, mb1 = 0.f, totb0 = 0.f, totb1 = 0.f;
#pragma unroll
        for (int s2 = 0; s2 < 8; ++s2) {
            const float x0 = SEGF[s2 * 128 + 2 * dp], x1 = SEGF[s2 * 128 + 2 * dp + 1], y0 = SEGB[s2 * 128 + 2 * dp], y1 = SEGB[s2 * 128 + 2 * dp + 1];
            if (s2 < seg) { offf0 += x0; offf1 += x1; } if (s2 < 4) { mf0 += x0; mf1 += x1; } totf0 += x0; totf1 += x1;
            if (s2 > seg) { offb0 += y0; offb1 += y1; } if (s2 >= 4) { mb0 += y0; mb1 += y1; } totb0 += y0; totb1 += y1;
        }
        const float emf0 = __builtin_amdgcn_exp2f(mf0), emf1 = __builtin_amdgcn_exp2f(mf1), emb0 = __builtin_amdgcn_exp2f(mb0), emb1 = __builtin_amdgcn_exp2f(mb1);
        const float etf0 = __builtin_amdgcn_exp2f(totf0 - mf0), etf1 = __builtin_amdgcn_exp2f(totf1 - mf1), etb0 = __builtin_amdgcn_exp2f(totb0 - mb0), etb1 = __builtin_amdgcn_exp2f(totb1 - mb1);
        unsigned kdf0[4], kdf1[4], kdb0[4], kdb1[4], vt0[4], vt1[4];
        float pk_a[6][2];
#pragma unroll
        for (int i = 0; i < 8; ++i) {
            const int t = 8 * seg + i; const size_t g = (R0 + t) * DM + h * 128 + 2 * dp;
            const float q0 = bflo(wq[i]), q1 = bfhi(wq[i]), v0 = bflo(wv[i]), v1 = bfhi(wv[i]);
#define EX2(x) __builtin_amdgcn_exp2f(x)
            const float kf0 = 1.f - EX2(bflo(wf[i])), kf1 = 1.f - EX2(bfhi(wf[i])), kb0 = 1.f - EX2(bflo(wb[i])), kb1 = 1.f - EX2(bfhi(wb[i]));
            const float Gf0 = offf0 + pf0[i], Gf1 = offf1 + pf1[i], Gb0 = offb0 + sb0[i], Gb1 = offb1 + sb1[i];
            const float ef0 = EX2(clamp80(Gf0 - mf0)), ef1 = EX2(clamp80(Gf1 - mf1)), eb0 = EX2(clamp80(Gb0 - mb0)), eb1 = EX2(clamp80(Gb1 - mb1));
            const float qtf0 = q0 * ef0, qtf1 = q1 * ef1, qtb0 = q0 * eb0, qtb1 = q1 * eb1;
            const float ktf0 = kf0 * __builtin_amdgcn_rcpf(ef0), ktf1 = kf1 * __builtin_amdgcn_rcpf(ef1), ktb0 = kb0 * __builtin_amdgcn_rcpf(eb0), ktb1 = kb1 * __builtin_amdgcn_rcpf(eb1);
            {
                const size_t gq = (R0 + 4 * (4 * (t >> 4) + (dp >> 4)) + ((dp >> 2) & 3)) * DM + h * 128 + (t & 15) * 8 + 2 * (dp & 3);
                *(unsigned*)(Uq + gq) = pk2(qtf0 * emf0, qtf1 * emf1);
                *(unsigned*)(Uqb + gq) = pk2(qtb0 * emb0, qtb1 * emb1); }
            *(LAS unsigned*)(lds + L_QF + t * QK_STR + 4 * dp) = pk2(qtf0, qtf1);
            *(LAS unsigned*)(lds + L_KF + t * QK_STR + 4 * dp) = pk2(ktf0, ktf1);
            *(LAS unsigned*)(lds + L_QB + t * QK_STR + 4 * dp) = pk2(qtb0, qtb1);
            *(LAS unsigned*)(lds + L_KB + t * QK_STR + 4 * dp) = pk2(ktb0, ktb1);
            const float a0 = ktf0 * etf0, a1 = ktf1 * etf1, c0 = ktb0 * etb0, c1 = ktb1 * etb1;
            if ((i & 1) == 0) { pk_a[0][0] = a0; pk_a[1][0] = a1; pk_a[2][0] = c0; pk_a[3][0] = c1; pk_a[4][0] = v0; pk_a[5][0] = v1; }
            else { kdf0[i >> 1] = pk2(pk_a[0][0], a0); kdf1[i >> 1] = pk2(pk_a[1][0], a1); kdb0[i >> 1] = pk2(pk_a[2][0], c0); kdb1[i >> 1] = pk2(pk_a[3][0], c1);
                   vt0[i >> 1] = pk2(pk_a[4][0], v0); vt1[i >> 1] = pk2(pk_a[5][0], v1); }
        }
        {
            const int d0 = 2 * dp, d1 = d0 + 1;
            const size_t g = (R0 + 4 * (4 * (d0 >> 5) + 2 * ((d0 >> 4) & 1) + (seg >> 2)) + (seg & 3)) * DM + h * 128 + (d0 & 15) * 8;
            const size_t g1 = g + 8;
            (void)d1;
            *(u32x4*)(Ulf + g) = (u32x4){kdf0[0], kdf0[1], kdf0[2], kdf0[3]}; *(u32x4*)(Ulf + g1) = (u32x4){kdf1[0], kdf1[1], kdf1[2], kdf1[3]};
            *(u32x4*)(Ulb + g) = (u32x4){kdb0[0], kdb0[1], kdb0[2], kdb0[3]}; *(u32x4*)(Ulb + g1) = (u32x4){kdb1[0], kdb1[1], kdb1[2], kdb1[3]};
            *(LAS u32x4*)(lds + L_VT + (2 * dp) * VT_STR + 16 * seg) = (u32x4){vt0[0], vt0[1], vt0[2], vt0[3]};
            *(LAS u32x4*)(lds + L_VT + (2 * dp + 1) * VT_STR + 16 * seg) = (u32x4){vt1[0], vt1[1], vt1[2], vt1[3]};
            if (seg == 0) { const size_t ao = ((size_t)(b * 128 + n)) * DM + h * 128 + 2 * dp; af[ao] = __builtin_amdgcn_exp2f(totf0); af[ao + 1] = __builtin_amdgcn_exp2f(totf1); ab[ao] = __builtin_amdgcn_exp2f(totb0); ab[ao + 1] = __builtin_amdgcn_exp2f(totb1); }
        }
        if (task + (int)gridDim.x < 4 * 128 * 8) HA_LOAD(task + (int)gridDim.x);
        __syncthreads();
        {
            const int ti = seg & 3, sp = seg >> 2;
            f32x4 accf[2], accb[2];
#pragma unroll
            for (int u = 0; u < 2; ++u) { accf[u] = (f32x4){0.f, 0.f, 0.f, 0.f}; accb[u] = accf[u]; }
#pragma unroll
            for (int ks = 0; ks < 4; ++ks) {
                const int ko = (ks * 32 + 8 * kg) * 2;
                const bf16x8 qf_ = *(const LAS bf16x8*)(lds + L_QF + (16 * ti + l15) * QK_STR + ko), qb_ = *(const LAS bf16x8*)(lds + L_QB + (16 * ti + l15) * QK_STR + ko);
#pragma unroll
                for (int u = 0; u < 2; ++u) { const int si = 2 * sp + u;
                    const bf16x8 kf_ = *(const LAS bf16x8*)(lds + L_KF + (16 * si + l15) * QK_STR + ko), kb_ = *(const LAS bf16x8*)(lds + L_KB + (16 * si + l15) * QK_STR + ko);
                    accf[u] = __builtin_amdgcn_mfma_f32_16x16x32_bf16(kf_, qf_, accf[u], 0, 0, 0);
                    accb[u] = __builtin_amdgcn_mfma_f32_16x16x32_bf16(kb_, qb_, accb[u], 0, 0, 0); }
            }
#pragma unroll
            for (int u = 0; u < 2; ++u) { const int si = 2 * sp + u; const int t = 16 * ti + l15; float o4[4];
#pragma unroll
                for (int j = 0; j < 4; ++j) { const int sidx = 16 * si + 4 * kg + j; o4[j] = (sidx <= t ? accf[u][j] : 0.f) + (sidx >= t ? accb[u][j] : 0.f); }
                *(LAS u32x2*)(lds + L_A + t * VT_STR + (16 * si + 4 * kg) * 2) = (u32x2){pk2(o4[0], o4[1]), pk2(o4[2], o4[3])}; }
        }
        __syncthreads();
        {
            f32x4 acco[4];
#pragma unroll
            for (int ti = 0; ti < 4; ++ti) acco[ti] = (f32x4){0.f, 0.f, 0.f, 0.f};
#pragma unroll
            for (int k2 = 0; k2 < 2; ++k2) { const int ko = (k2 * 32 + 8 * kg) * 2;
                const bf16x8 vt_ = *(const LAS bf16x8*)(lds + L_VT + (16 * seg + l15) * VT_STR + ko);
#pragma unroll
                for (int ti = 0; ti < 4; ++ti) { const bf16x8 a_ = *(const LAS bf16x8*)(lds + L_A + (16 * ti + l15) * VT_STR + ko);
                    acco[ti] = __builtin_amdgcn_mfma_f32_16x16x32_bf16(vt_, a_, acco[ti], 0, 0, 0); } }
#pragma unroll
            for (int ti = 0; ti < 4; ++ti) *(u32x2*)(Uo + (R0 + 16 * ti + l15) * DM + h * 128 + 16 * seg + 4 * kg) = (u32x2){pk2(acco[ti][0], acco[ti][1]), pk2(acco[ti][2], acco[ti][3])};
        }
    }
}

template <int PITCH> __device__ __forceinline__ bf16x8 ld_T(const LAS unsigned char* p) {
    unsigned w[4];
#pragma unroll
    for (int q = 0; q < 4; ++q) w[q] = (unsigned)*(const LAS unsigned short*)(p + (2 * q) * PITCH) | ((unsigned)*(const LAS unsigned short*)(p + (2 * q + 1) * PITCH) << 16);
    return __builtin_bit_cast(bf16x8, (u32x4){w[0], w[1], w[2], w[3]});
}
__device__ __forceinline__ bf16x8 ld_vT(const LAS unsigned char* p) { return ld_T<128>(p); }
#define TR16_ASM(o, b, HO, K2O, K2HO) asm volatile( \
    "ds_read_b64_tr_b16 %0, %16\n\tds_read_b64_tr_b16 %1, %16 offset:" #HO "\n\tds_read_b64_tr_b16 %2, %16 offset:" #K2O "\n\tds_read_b64_tr_b16 %3, %16 offset:" #K2HO "\n\t" \
    "ds_read_b64_tr_b16 %4, %17\n\tds_read_b64_tr_b16 %5, %17 offset:" #HO "\n\tds_read_b64_tr_b16 %6, %17 offset:" #K2O "\n\tds_read_b64_tr_b16 %7, %17 offset:" #K2HO "\n\t" \
    "ds_read_b64_tr_b16 %8, %18\n\tds_read_b64_tr_b16 %9, %18 offset:" #HO "\n\tds_read_b64_tr_b16 %10, %18 offset:" #K2O "\n\tds_read_b64_tr_b16 %11, %18 offset:" #K2HO "\n\t" \
    "ds_read_b64_tr_b16 %12, %19\n\tds_read_b64_tr_b16 %13, %19 offset:" #HO "\n\tds_read_b64_tr_b16 %14, %19 offset:" #K2O "\n\tds_read_b64_tr_b16 %15, %19 offset:" #K2HO "\n\t" \
    "s_waitcnt lgkmcnt(0)" \
    : "=&v"(o[0]), "=&v"(o[1]), "=&v"(o[2]), "=&v"(o[3]), "=&v"(o[4]), "=&v"(o[5]), "=&v"(o[6]), "=&v"(o[7]), "=&v"(o[8]), "=&v"(o[9]), "=&v"(o[10]), "=&v"(o[11]), "=&v"(o[12]), "=&v"(o[13]), "=&v"(o[14]), "=&v"(o[15]) \
    : "v"(b[0]), "v"(b[1]), "v"(b[2]), "v"(b[3]) : "memory")
#define TR16_FRAG(o, XI, KI) __builtin_bit_cast(bf16x8, (u32x4){o[4 * (XI) + 2 * (KI)][0], o[4 * (XI) + 2 * (KI)][1], o[4 * (XI) + 2 * (KI) + 1][0], o[4 * (XI) + 2 * (KI) + 1][1]})
constexpr int S_STR = 272;
constexpr int S_BUF64 = 64 * S_STR;
struct HgO { bf16x8 q[4]; u32x2 o[4]; bf16x8 v[2]; };
struct HgS { bf16x8 k[2][2]; f32x4 a[2]; };
constexpr int L_HV = 2 * S_BUF64;
template <int DIR>
__device__ __forceinline__ void hgrn_p2b(const bf16_t* Qg, const bf16_t* Kd, const bf16_t* VT, bf16_t* O, const float* av, LAS unsigned char* lds) {
    int tid = threadIdx.x; asm volatile("" : "+v"(tid));
    const int lane = tid & 63, wave = __builtin_amdgcn_readfirstlane(tid >> 6), role = wave >> 2, w4 = wave & 3, l15 = lane & 15, kg = lane >> 4;
    const int bx = blockIdx.x & 7, by = (blockIdx.x >> 3) & 15;
    const int dvh = by & 1, bh = bx + 8 * (by >> 2), b = bh >> 3, h = bh & 7;
    for (int i = tid; i < 2 * S_BUF64 / 4; i += 512) ((LAS unsigned*)lds)[i] = 0u;
    __syncthreads();
    const size_t fo_ = ((size_t)b * SEQ + kg) * DM + h * 128 + l15 * 8;
#define HG_N(i) (DIR ? 127 - (i) : (i))
    if (role == 0) {
        const bf16_t* qb = Qg + fo_ + (size_t)(16 * w4) * DM;
        bf16_t* ob = O + ((size_t)b * SEQ + 16 * w4 + l15) * DM + h * 128 + 64 * dvh + 4 * kg;
        const bf16_t* vb = VT + ((size_t)b * SEQ + 16 * w4 + (lane >> 3)) * DM + h * 128 + 64 * dvh + (lane & 7) * 8;
        LAS unsigned char* vl = lds + L_HV + (16 * w4 + (lane >> 3)) * 128;
#define HGO_LOAD(dst, n) do { const size_t c_ = (size_t)(64 * (n)) * DM; \
        _Pragma("unroll") for (int u = 0; u < 2; ++u) dst.v[u] = *(const bf16x8*)(vb + c_ + (size_t)(8 * u) * DM); \
        if (!DIR) { _Pragma("unroll") for (int mm = 0; mm < 4; ++mm) dst.o[mm] = *(const u32x2*)(ob + c_ + 16 * mm); } \
        _Pragma("unroll") for (int ks = 0; ks < 4; ++ks) dst.q[ks] = *(const bf16x8*)(qb + c_ + (size_t)(4 * ks) * DM); } while (0)
#define HGO_STEP(cur, mid, far, i) do { const int bufc = (i) & 1; \
        if ((i) + 2 < 128) HGO_LOAD(far, HG_N((i) + 2)); \
        if ((i) + 1 < 128) { _Pragma("unroll") for (int u = 0; u < 2; ++u) *(LAS bf16x8*)(vl + (bufc ^ 1) * 8192 + u * 1024 + (((lane & 7) ^ (2 * u)) << 4)) = mid.v[u]; } \
        f32x4 acco[4]; \
        _Pragma("unroll") for (int mm = 0; mm < 4; ++mm) acco[mm] = (f32x4){0.f, 0.f, 0.f, 0.f}; \
        _Pragma("unroll") for (int ks = 0; ks < 4; ++ks) _Pragma("unroll") for (int mm = 0; mm < 4; ++mm) { \
            const bf16x8 sf = *(const LAS bf16x8*)(lds + bufc * S_BUF64 + (16 * mm + l15) * S_STR + (ks * 32 + 8 * kg) * 2); \
            acco[mm] = __builtin_amdgcn_mfma_f32_16x16x32_bf16(sf, cur.q[ks], acco[mm], 0, 0, 0); } \
        bf16_t* op = ob + (size_t)(64 * HG_N(i)) * DM; \
        _Pragma("unroll") for (int mm = 0; mm < 4; ++mm) { \
            if (!DIR) *(u32x2*)(op + 16 * mm) = (u32x2){pk2(bflo(cur.o[mm].x) + acco[mm][0], bfhi(cur.o[mm].x) + acco[mm][1]), pk2(bflo(cur.o[mm].y) + acco[mm][2], bfhi(cur.o[mm].y) + acco[mm][3])}; \
            else      *(u32x2*)(op + 16 * mm) = (u32x2){pk2(acco[mm][0], acco[mm][1]), pk2(acco[mm][2], acco[mm][3])}; } \
        __syncthreads(); } while (0)
        HgO A, B, C;
#pragma unroll
        for (int mm = 0; mm < 4; ++mm) { A.o[mm] = (u32x2){0u, 0u}; B.o[mm] = A.o[mm]; C.o[mm] = A.o[mm]; }
        HGO_LOAD(A, HG_N(0)); HGO_LOAD(B, HG_N(1));
#pragma unroll
        for (int u = 0; u < 2; ++u) *(LAS bf16x8*)(vl + u * 1024 + (((lane & 7) ^ (2 * u)) << 4)) = A.v[u];
        __syncthreads();
        for (int i = 0; i < 126; i += 3) { HGO_STEP(A, B, C, i); HGO_STEP(B, C, A, i + 1); HGO_STEP(C, A, B, i + 2); }
        HGO_STEP(A, B, C, 126); HGO_STEP(B, C, A, 127);
#undef HGO_STEP
#undef HGO_LOAD
    } else {
        const bf16_t* kb = Kd + fo_ + (size_t)(16 * w4) * DM;
        const float* ab = av + (size_t)(b * 128) * DM + h * 128 + 32 * w4 + 4 * kg;
        unsigned vtr[4];
#pragma unroll
        for (int x = 0; x < 4; ++x) vtr[x] = (unsigned)(size_t)lds + L_HV + (8 * kg + (l15 >> 2)) * 128 + (((2 * x + ((l15 & 3) >> 1)) ^ (2 * (kg & 1))) << 4) + 8 * (l15 & 1);
        f32x4 accS[2][4];
#pragma unroll
        for (int m = 0; m < 2; ++m)
#pragma unroll
            for (int nn = 0; nn < 4; ++nn) accS[m][nn] = (f32x4){0.f, 0.f, 0.f, 0.f};
#define HGS_LOAD(dst, n) do { const size_t c_ = (size_t)(64 * (n)) * DM; \
        _Pragma("unroll") for (int m = 0; m < 2; ++m) _Pragma("unroll") for (int k2 = 0; k2 < 2; ++k2) dst.k[m][k2] = *(const bf16x8*)(kb + c_ + (size_t)(8 * m + 4 * k2) * DM); \
        _Pragma("unroll") for (int m = 0; m < 2; ++m) dst.a[m] = *(const f32x4*)(ab + (size_t)(n) * DM + 16 * m); } while (0)
#define HGS_STEP(cur, far, i) do { const int bufc = (i) & 1; \
        if ((i) + 2 < 128) HGS_LOAD(far, HG_N((i) + 2)); \
        u32x2 vo[16]; { unsigned vb_[4]; _Pragma("unroll") for (int x = 0; x < 4; ++x) vb_[x] = vtr[x] + bufc * 8192; TR16_ASM(vo, vb_, 512, 4096, 4608); } \
        _Pragma("unroll") for (int nn = 0; nn < 4; ++nn) { bf16x8 vf[2]; \
          _Pragma("unroll") for (int k2 = 0; k2 < 2; ++k2) vf[k2] = TR16_FRAG(vo, nn, k2); \
          _Pragma("unroll") for (int m = 0; m < 2; ++m) { accS[m][nn] = accS[m][nn] * cur.a[m]; \
            _Pragma("unroll") for (int k2 = 0; k2 < 2; ++k2) accS[m][nn] = __builtin_amdgcn_mfma_f32_16x16x32_bf16(cur.k[m][k2], vf[k2], accS[m][nn], 0, 0, 0); \
            *(LAS u32x2*)(lds + (bufc ^ 1) * S_BUF64 + (16 * nn + l15) * S_STR + (32 * w4 + 16 * m + 4 * kg) * 2) = (u32x2){pk2(accS[m][nn][0], accS[m][nn][1]), pk2(accS[m][nn][2], accS[m][nn][3])}; } } \
        __syncthreads(); } while (0)
        HgS A, B, C;
        HGS_LOAD(A, HG_N(0)); HGS_LOAD(B, HG_N(1));
        __syncthreads();
        for (int i = 0; i < 126; i += 3) { HGS_STEP(A, C, i); HGS_STEP(B, A, i + 1); HGS_STEP(C, B, i + 2); }
        HGS_STEP(A, C, 126); HGS_STEP(B, A, 127);
#undef HGS_STEP
#undef HGS_LOAD
    }
#undef HG_N
}

constexpr int F_TS = 256, F_TB = 64 * F_TS;
constexpr int L_FS = 0, L_FV = 2 * F_TB, L_FQT = L_FV + 2 * 8192, L_FKT = L_FQT + 2 * F_TB, L_FQG = L_FKT + 2 * F_TB, L_FSEG = L_FQG + 2 * F_TB, L_FAV = L_FSEG + 8 * 128 * 4, L_FET = L_FAV + 2 * 512, L_FEND = L_FET + 2 * 512;
static_assert(L_FEND <= LDS_XB, "fused HGRN pass LDS images overflow");
#define TR8_ASM(o, b, HO, K2O, K2HO) asm volatile( \
    "ds_read_b64_tr_b16 %0, %8\n\tds_read_b64_tr_b16 %1, %8 offset:" #HO "\n\tds_read_b64_tr_b16 %2, %8 offset:" #K2O "\n\tds_read_b64_tr_b16 %3, %8 offset:" #K2HO "\n\t" \
    "ds_read_b64_tr_b16 %4, %9\n\tds_read_b64_tr_b16 %5, %9 offset:" #HO "\n\tds_read_b64_tr_b16 %6, %9 offset:" #K2O "\n\tds_read_b64_tr_b16 %7, %9 offset:" #K2HO "\n\t" \
    "s_waitcnt lgkmcnt(0)" \
    : "=&v"(o[0]), "=&v"(o[1]), "=&v"(o[2]), "=&v"(o[3]), "=&v"(o[4]), "=&v"(o[5]), "=&v"(o[6]), "=&v"(o[7]) : "v"(b[0]), "v"(b[1]) : "memory")
#define TR8C_ASM(o, b, HO) asm volatile( \
    "ds_read_b64_tr_b16 %0, %8\n\tds_read_b64_tr_b16 %1, %8 offset:" #HO "\n\tds_read_b64_tr_b16 %2, %9\n\tds_read_b64_tr_b16 %3, %9 offset:" #HO "\n\t" \
    "ds_read_b64_tr_b16 %4, %10\n\tds_read_b64_tr_b16 %5, %10 offset:" #HO "\n\tds_read_b64_tr_b16 %6, %11\n\tds_read_b64_tr_b16 %7, %11 offset:" #HO "\n\t" \
    "s_waitcnt lgkmcnt(0)" \
    : "=&v"(o[0]), "=&v"(o[1]), "=&v"(o[2]), "=&v"(o[3]), "=&v"(o[4]), "=&v"(o[5]), "=&v"(o[6]), "=&v"(o[7]) : "v"(b[0]), "v"(b[1]), "v"(b[2]), "v"(b[3]) : "memory")
#define TR_PAIR(o, I) __builtin_bit_cast(bf16x8, (u32x4){o[2 * (I)][0], o[2 * (I)][1], o[2 * (I) + 1][0], o[2 * (I) + 1][1]})
#define TR8B_ASM(o, b, K2O) asm volatile( \
    "ds_read_b64_tr_b16 %0, %8\n\tds_read_b64_tr_b16 %1, %9\n\tds_read_b64_tr_b16 %2, %8 offset:" #K2O "\n\tds_read_b64_tr_b16 %3, %9 offset:" #K2O "\n\t" \
    "ds_read_b64_tr_b16 %4, %10\n\tds_read_b64_tr_b16 %5, %11\n\tds_read_b64_tr_b16 %6, %10 offset:" #K2O "\n\tds_read_b64_tr_b16 %7, %11 offset:" #K2O "\n\t" \
    "s_waitcnt lgkmcnt(0)" \
    : "=&v"(o[0]), "=&v"(o[1]), "=&v"(o[2]), "=&v"(o[3]), "=&v"(o[4]), "=&v"(o[5]), "=&v"(o[6]), "=&v"(o[7]) : "v"(b[0]), "v"(b[1]), "v"(b[2]), "v"(b[3]) : "memory")
struct HfIn { unsigned q[8], l[8]; bf16x8 v[2]; };
template <int DIR>
__device__ __forceinline__ void hgrn_fused(const bf16_t* Uq, const bf16_t* Ul, const bf16_t* Uv, bf16_t* O, LAS unsigned char* lds) {
    int tid = threadIdx.x; asm volatile("" : "+v"(tid));
    const int lane = tid & 63, wave = __builtin_amdgcn_readfirstlane(tid >> 6), seg = wave, role = wave >> 2, w4 = wave & 3, l15 = lane & 15, kg = lane >> 4, dp = lane;
    const int bx = blockIdx.x & 7, by = (blockIdx.x >> 3) & 15;
    const int dvh = by & 1, bh = bx + 8 * (by >> 2), b = bh >> 3, h = bh & 7;
    for (int i = tid; i < 2 * F_TB / 4; i += 512) ((LAS unsigned*)(lds + L_FS))[i] = 0u;
    LAS float* SEG = (LAS float*)(lds + L_FSEG);
    const size_t eb = ((size_t)b * SEQ + 8 * seg) * DM + h * 128 + 2 * dp;
    const bf16_t* vb = Uv + ((size_t)b * SEQ + 16 * w4 + (lane >> 3)) * DM + h * 128 + 64 * dvh + (lane & 7) * 8;
    LAS unsigned char* vl = lds + L_FV + (16 * w4 + (lane >> 3)) * 128;
    bf16_t* ob = O + ((size_t)b * SEQ + 16 * w4 + l15) * DM + h * 128 + 64 * dvh + 4 * kg;
    const unsigned lds0 = (unsigned)(size_t)lds;
    int ew[8];
#pragma unroll
    for (int i8 = 0; i8 < 8; ++i8) { const int t = 8 * seg + i8; ew[i8] = t * F_TS + (((dp >> 2) ^ (t & 15)) << 4) + (dp & 3) * 4; }
#define HF_N(i) (DIR ? 127 - (i) : (i))
#define HF_LOAD(RC, dst, n) do { const size_t c_ = (size_t)(64 * (n)) * DM; \
        _Pragma("unroll") for (int i = 0; i < 8; ++i) { dst.q[i] = *(const unsigned*)(Uq + eb + c_ + (size_t)i * DM); dst.l[i] = *(const unsigned*)(Ul + eb + c_ + (size_t)i * DM); } \
        if (RC == 0) { _Pragma("unroll") for (int u = 0; u < 2; ++u) dst.v[u] = *(const bf16x8*)(vb + c_ + (size_t)(8 * u) * DM); } } while (0)
#define HF_VPUT(src, par) do { _Pragma("unroll") for (int u = 0; u < 2; ++u) *(LAS bf16x8*)(vl + (par) * 8192 + u * 1024 + (((lane & 7) ^ (2 * u)) << 4)) = src.v[u]; } while (0)
#define HF_E1(src) \
        { float r0 = 0.f, r1 = 0.f; \
          _Pragma("unroll") for (int i8 = 0; i8 < 8; ++i8) { r0 += bflo(src.l[i8]); r1 += bfhi(src.l[i8]); } \
          SEG[seg * 128 + 2 * dp] = r0; SEG[seg * 128 + 2 * dp + 1] = r1; }
#define HF_E2(src, par) do { \
          float off0 = 0.f, off1 = 0.f, m0 = 0.f, m1 = 0.f, tot0 = 0.f, tot1 = 0.f; \
          _Pragma("unroll") for (int s2 = 0; s2 < 8; ++s2) { const float x0 = SEG[s2 * 128 + 2 * dp], x1 = SEG[s2 * 128 + 2 * dp + 1]; \
              if (DIR ? (s2 > seg) : (s2 < seg)) { off0 += x0; off1 += x1; } if (DIR ? (s2 >= 4) : (s2 < 4)) { m0 += x0; m1 += x1; } tot0 += x0; tot1 += x1; } \
          const f32v2_t em = {__builtin_amdgcn_exp2f(m0), __builtin_amdgcn_exp2f(m1)}; const f32v2_t one = {1.f, 1.f}; \
          f32v2_t g = {off0 - m0, off1 - m1};        \
          _Pragma("unroll") for (int j8 = 0; j8 < 8; ++j8) { const int i8 = DIR ? 7 - j8 : j8; \
              const f32v2_t l = {bflo(src.l[i8]), bfhi(src.l[i8])}, q = {bflo(src.q[i8]), bfhi(src.q[i8])}; g += l; \
              const f32v2_t f = {__builtin_amdgcn_exp2f(l.x), __builtin_amdgcn_exp2f(l.y)}, k = one - f; \
              const f32v2_t gc = {__builtin_amdgcn_fmed3f(g.x, -115.f, 115.f), __builtin_amdgcn_fmed3f(g.y, -115.f, 115.f)}; \
              const f32v2_t e = {__builtin_amdgcn_exp2f(gc.x), __builtin_amdgcn_exp2f(gc.y)}, r = {__builtin_amdgcn_rcpf(e.x), __builtin_amdgcn_rcpf(e.y)}; \
              const f32v2_t qt = q * e, kt = k * r, qg = qt * em; \
              *(LAS unsigned*)(lds + L_FQT + (par) * F_TB + ew[i8]) = __builtin_bit_cast(unsigned, __builtin_convertvector(qt, bf16v2_t)); \
              *(LAS unsigned*)(lds + L_FKT + (par) * F_TB + ew[i8]) = __builtin_bit_cast(unsigned, __builtin_convertvector(kt, bf16v2_t)); \
              *(LAS unsigned*)(lds + L_FQG + (par) * F_TB + ew[i8]) = __builtin_bit_cast(unsigned, __builtin_convertvector(qg, bf16v2_t)); } \
          if (seg == 0) { LAS float* av_ = (LAS float*)(lds + L_FAV + (par) * 512); LAS float* et_ = (LAS float*)(lds + L_FET + (par) * 512); \
              av_[2 * dp] = __builtin_amdgcn_exp2f(tot0); av_[2 * dp + 1] = __builtin_amdgcn_exp2f(tot1); et_[2 * dp] = __builtin_amdgcn_exp2f(tot0 - m0); et_[2 * dp + 1] = __builtin_amdgcn_exp2f(tot1 - m1); } } while (0)
#define HF_MO(i, bufc) do { \
            f32x4 acco[4], accp[4]; \
            _Pragma("unroll") for (int mm = 0; mm < 4; ++mm) { acco[mm] = (f32x4){0.f, 0.f, 0.f, 0.f}; accp[mm] = acco[mm]; } \
            _Pragma("unroll") for (int ks = 0; ks < 4; ++ks) { \
                const bf16x8 qg = *(const LAS bf16x8*)(lds + L_FQG + (bufc) * F_TB + (16 * w4) * F_TS + ro[ks]); \
                _Pragma("unroll") for (int mm = 0; mm < 4; ++mm) { const bf16x8 sf = *(const LAS bf16x8*)(lds + L_FS + (bufc) * F_TB + (16 * mm) * F_TS + ro[ks]); \
                    acco[mm] = __builtin_amdgcn_mfma_f32_16x16x32_bf16(sf, qg, acco[mm], 0, 0, 0); } } \
            _Pragma("unroll") for (int si = 0; si < 4; ++si) { \
                if (DIR ? si >= w4 : si <= w4) { \
                    _Pragma("unroll") for (int ks = 0; ks < 4; ++ks) { const bf16x8 kt_ = *(const LAS bf16x8*)(lds + L_FKT + (bufc) * F_TB + (16 * si) * F_TS + ro[ks]); \
                        const bf16x8 qt_ = *(const LAS bf16x8*)(lds + L_FQT + (bufc) * F_TB + (16 * w4) * F_TS + ro[ks]); \
                        accp[si] = __builtin_amdgcn_mfma_f32_16x16x32_bf16(kt_, qt_, accp[si], 0, 0, 0); } \
                    if (si == w4) { _Pragma("unroll") for (int r = 0; r < 4; ++r) { const bool keep = DIR ? (4 * kg + r >= l15) : (4 * kg + r <= l15); accp[si][r] = keep ? accp[si][r] : 0.f; } } } } \
              \
            u32x2 oo[16]; { unsigned ob_[4]; _Pragma("unroll") for (int x = 0; x < 4; ++x) ob_[x] = otr[x] + (bufc) * 8192; TR16_ASM(oo, ob_, 2048, 4096, 6144); } \
            _Pragma("unroll") for (int kp = 0; kp < 2; ++kp) { \
                if (DIR ? (2 * kp + 1 >= w4) : (2 * kp <= w4)) { \
                    const bf16x8 pf = __builtin_bit_cast(bf16x8, (u32x4){pk2(accp[2 * kp][0], accp[2 * kp][1]), pk2(accp[2 * kp][2], accp[2 * kp][3]), pk2(accp[2 * kp + 1][0], accp[2 * kp + 1][1]), pk2(accp[2 * kp + 1][2], accp[2 * kp + 1][3])}); \
                    _Pragma("unroll") for (int mm = 0; mm < 4; ++mm) acco[mm] = __builtin_amdgcn_mfma_f32_16x16x32_bf16(TR16_FRAG(oo, mm, kp), pf, acco[mm], 0, 0, 0); } } \
            bf16_t* op = ob + (size_t)(64 * HF_N(i)) * DM; \
            _Pragma("unroll") for (int mm = 0; mm < 4; ++mm) *(u32x2*)(op + 16 * mm) = (u32x2){pk2(acco[mm][0], acco[mm][1]), pk2(acco[mm][2], acco[mm][3])}; } while (0)
#define HF_MS(bufc) do { \
            f32x4 av[2], et[2]; _Pragma("unroll") for (int m = 0; m < 2; ++m) { av[m] = *(const LAS f32x4*)(lds + L_FAV + (bufc) * 512 + (32 * w4 + 16 * m + 4 * kg) * 4); et[m] = *(const LAS f32x4*)(lds + L_FET + (bufc) * 512 + (32 * w4 + 16 * m + 4 * kg) * 4); } \
            u32x2 ko[8]; \
            { unsigned kb_[4]; _Pragma("unroll") for (int x = 0; x < 4; ++x) kb_[x] = ktr[x] + (bufc) * F_TB; TR8B_ASM(ko, kb_, 8192); } \
            u32x2 vo[16]; { unsigned vb_[4]; _Pragma("unroll") for (int x = 0; x < 4; ++x) vb_[x] = vtr[x] + (bufc) * 8192; TR16_ASM(vo, vb_, 512, 4096, 4608); } \
            { \
              _Pragma("unroll") for (int nn = 0; nn < 4; ++nn) _Pragma("unroll") for (int m = 0; m < 2; ++m) { f32x4 tmp = (f32x4){0.f, 0.f, 0.f, 0.f}; \
                _Pragma("unroll") for (int k2 = 0; k2 < 2; ++k2) tmp = __builtin_amdgcn_mfma_f32_16x16x32_bf16(TR16_FRAG(ko, m, k2), TR16_FRAG(vo, nn, k2), tmp, 0, 0, 0); \
                accS[m][nn] = accS[m][nn] * av[m] + tmp * et[m]; \
                *(LAS u32x2*)(lds + L_FS + ((bufc) ^ 1) * F_TB + (16 * nn) * F_TS + wo[m]) = (u32x2){pk2(accS[m][nn][0], accS[m][nn][1]), pk2(accS[m][nn][2], accS[m][nn][3])}; } } } while (0)
#define HF_STEP(RC, nx, ld, i) do { const int bufc = (i) & 1; \
        if ((i) + 2 < 128) HF_LOAD(RC, ld, HF_N((i) + 2)); \
        if ((i) + 1 < 128) { HF_E1(nx) \
            __syncthreads(); \
            if (RC == 0) { HF_VPUT(nx, bufc ^ 1); HF_E2(nx, bufc ^ 1); HF_MO(i, bufc); } else { HF_MS(bufc); HF_E2(nx, bufc ^ 1); } \
        } else { if (RC == 0) HF_MO(i, bufc); else HF_MS(bufc); } \
        __syncthreads(); } while (0)
    if (role == 0) {
        int ro[4];
#pragma unroll
        for (int ks = 0; ks < 4; ++ks) ro[ks] = l15 * F_TS + (((4 * ks + kg) ^ l15) << 4);
        unsigned otr[4];
#pragma unroll
        for (int x = 0; x < 4; ++x) otr[x] = lds0 + L_FV + (4 * kg + (l15 >> 2)) * 128 + (((2 * x + ((l15 & 3) >> 1)) ^ (2 * (kg >> 1))) << 4) + 8 * (l15 & 1);
        int wo[2] = {0, 0}; unsigned vtr[4] = {0u, 0u, 0u, 0u}, ktr[4] = {0u, 0u, 0u, 0u};
        f32x4 accS[2][4];
        HfIn A, B;
        HF_LOAD(0, A, HF_N(0)); HF_LOAD(0, B, HF_N(1));
        { HF_E1(A)
          __syncthreads();
          HF_E2(A, 0); HF_VPUT(A, 0); }
        __syncthreads();
        for (int i = 0; i < 128; i += 2) { HF_STEP(0, B, A, i); HF_STEP(0, A, B, i + 1); }
    } else {
        int wo[2];
#pragma unroll
        for (int m = 0; m < 2; ++m) wo[m] = l15 * F_TS + (((4 * w4 + 2 * m + (kg >> 1)) ^ l15) << 4) + ((kg & 1) << 3);
        unsigned vtr[4], ktr[4];
#pragma unroll
        for (int x = 0; x < 4; ++x) {
            vtr[x] = lds0 + L_FV + (8 * kg + (l15 >> 2)) * 128 + (((2 * x + ((l15 & 3) >> 1)) ^ (2 * (kg & 1))) << 4) + 8 * (l15 & 1);
            const int m = x >> 1, hf = x & 1, t = 8 * kg + 4 * hf + (l15 >> 2);
            ktr[x] = lds0 + L_FKT + t * F_TS + (((4 * w4 + 2 * m + ((l15 & 3) >> 1)) ^ (t & 15)) << 4) + 8 * (l15 & 1); }
        int ro[4] = {0, 0, 0, 0}; unsigned otr[4] = {0u, 0u, 0u, 0u};
        f32x4 accS[2][4];
#pragma unroll
        for (int m = 0; m < 2; ++m)
#pragma unroll
            for (int nn = 0; nn < 4; ++nn) accS[m][nn] = (f32x4){0.f, 0.f, 0.f, 0.f};
        HfIn A, B;
        HF_LOAD(1, A, HF_N(0)); HF_LOAD(1, B, HF_N(1));
        { HF_E1(A)
          __syncthreads();
          HF_E2(A, 0); }
        __syncthreads();
        for (int i = 0; i < 128; i += 2) { HF_STEP(1, B, A, i); HF_STEP(1, A, B, i + 1); }
    }
#undef HF_STEP
#undef HF_MS
#undef HF_MO
#undef HF_E2
#undef HF_E1
#undef HF_VPUT
#undef HF_LOAD
#undef HF_N
}

constexpr int RA_VT = 0, RA_A = 256 * 144;
__device__ __forceinline__ void ret_p2a(const bf16_t* Uq, const bf16_t* Uk, const bf16_t* Uv, bf16_t* Ukt, bf16_t* Uvt, bf16_t* Uo, LAS unsigned char* lds) {
    int tid = threadIdx.x; asm volatile("" : "+v"(tid));
    const int lane = tid & 63, wave = __builtin_amdgcn_readfirstlane(tid >> 6), l15 = lane & 15, kg = lane >> 4;
    const int dq = tid & 127, seg = wave >> 1;
    const int ti = wave & 3, sp = wave >> 2;
    unsigned wk[16], wv[16]; bf16x8 qf[8], kf[2][8];
#define RA_LOADE(tk) do { const int h_ = (tk) & 3, n_ = ((tk) >> 2) & 127, b_ = (tk) >> 9; const size_t R0_ = (size_t)b_ * SEQ + 64 * n_; \
        _Pragma("unroll") for (int i = 0; i < 16; ++i) { wv[i] = *(const unsigned*)(Uv + (R0_ + 16 * seg + i) * DM + h_ * 256 + 2 * dq); \
            const int f = 8 * seg + (dq >> 4), L = i + 16 * ((dq >> 2) & 3); \
            wk[i] = *(const unsigned*)(Uk + (R0_ + 2 * f + (L >> 5)) * DM + h_ * 256 + (L & 31) * 8 + 2 * (dq & 3)); } } while (0)
#define RA_LOADF(tk) do { const int h_ = (tk) & 3, n_ = ((tk) >> 2) & 127, b_ = (tk) >> 9; const size_t R0_ = (size_t)b_ * SEQ + 64 * n_; \
        _Pragma("unroll") for (int ks = 0; ks < 8; ++ks) { qf[ks] = *(const bf16x8*)(Uq + (R0_ + 2 * (8 * ti + ks) + (lane >> 5)) * DM + h_ * 256 + (lane & 31) * 8); \
            _Pragma("unroll") for (int u = 0; u < 2; ++u) kf[u][ks] = *(const bf16x8*)(Uk + (R0_ + 2 * (8 * (2 * sp + u) + ks) + (lane >> 5)) * DM + h_ * 256 + (lane & 31) * 8); } } while (0)
    if ((int)blockIdx.x < 4 * 128 * 4) { RA_LOADF((int)blockIdx.x); RA_LOADE((int)blockIdx.x); }
    for (int task = blockIdx.x; task < 4 * 128 * 4; task += gridDim.x) {
        const int h = task & 3, n = (task >> 2) & 127, b = task >> 9;
        const size_t R0 = (size_t)b * SEQ + 64 * n;
        const float lg = __log2f(1.0f - exp2f(-5.0f - (float)h));
        const bool more = task + (int)gridDim.x < 4 * 128 * 4;
        f32x4 accp[2];
#pragma unroll
        for (int u = 0; u < 2; ++u) accp[u] = (f32x4){0.f, 0.f, 0.f, 0.f};
#pragma unroll
        for (int ks = 0; ks < 8; ++ks)
#pragma unroll
            for (int u = 0; u < 2; ++u) accp[u] = __builtin_amdgcn_mfma_f32_16x16x32_bf16(kf[u][ks], qf[ks], accp[u], 0, 0, 0);
        if (more) RA_LOADF(task + (int)gridDim.x);
        __syncthreads();
#pragma unroll
        for (int u = 0; u < 2; ++u) { const int si = 2 * sp + u; const int t = 16 * ti + l15; float o4[4];
#pragma unroll
            for (int j = 0; j < 4; ++j) { const int sidx = 16 * si + 4 * kg + j; const int dd = t > sidx ? t - sidx : sidx - t; o4[j] = accp[u][j] * exp2f((float)dd * lg) * (dd == 0 ? 2.f : 1.f); }
            *(LAS u32x2*)(lds + RA_A + t * VT_STR + (16 * si + 4 * kg) * 2) = (u32x2){pk2(o4[0], o4[1]), pk2(o4[2], o4[3])}; }
        {
            unsigned kt0[8], kt1[8], vt0[8], vt1[8];
#pragma unroll
            for (int i2 = 0; i2 < 8; ++i2) {
                const unsigned ka = wk[2 * i2], kb = wk[2 * i2 + 1], va = wv[2 * i2], vb = wv[2 * i2 + 1];
                kt0[i2] = (ka & 0xffffu) | (kb << 16); kt1[i2] = (ka >> 16) | (kb & 0xffff0000u);
                vt0[i2] = (va & 0xffffu) | (vb << 16); vt1[i2] = (va >> 16) | (vb & 0xffff0000u);
            }
#define RA_ADDR(d, p) ((R0 + 2 * (((d) >> 4) * 2 + (seg >> 1)) + ((((d) & 15) + 16 * (2 * (seg & 1) + (p))) >> 5)) * DM + h * 256 + ((((d) & 15) + 16 * (2 * (seg & 1) + (p))) & 31) * 8)
            const int d0 = 2 * dq, d1 = d0 + 1;
            (void)Ukt;
            (void)Uvt;
#undef RA_ADDR
            LAS unsigned char* l0 = lds + RA_VT + (2 * dq) * VT_STR + 32 * seg;
            *(LAS u32x4*)(l0) = (u32x4){vt0[0], vt0[1], vt0[2], vt0[3]}; *(LAS u32x4*)(l0 + 16) = (u32x4){vt0[4], vt0[5], vt0[6], vt0[7]};
            *(LAS u32x4*)(l0 + VT_STR) = (u32x4){vt1[0], vt1[1], vt1[2], vt1[3]}; *(LAS u32x4*)(l0 + VT_STR + 16) = (u32x4){vt1[4], vt1[5], vt1[6], vt1[7]};
        }
        if (more) RA_LOADE(task + (int)gridDim.x);
        __syncthreads();
        {
            f32x4 acco[2][4];
#pragma unroll
            for (int u = 0; u < 2; ++u)
#pragma unroll
                for (int t4 = 0; t4 < 4; ++t4) acco[u][t4] = (f32x4){0.f, 0.f, 0.f, 0.f};
#pragma unroll
            for (int k2 = 0; k2 < 2; ++k2) { const int ko = (k2 * 32 + 8 * kg) * 2;
                bf16x8 a_[4];
#pragma unroll
                for (int t4 = 0; t4 < 4; ++t4) a_[t4] = *(const LAS bf16x8*)(lds + RA_A + (16 * t4 + l15) * VT_STR + ko);
#pragma unroll
                for (int u = 0; u < 2; ++u) { const bf16x8 vt_ = *(const LAS bf16x8*)(lds + RA_VT + (16 * (2 * wave + u) + l15) * VT_STR + ko);
#pragma unroll
                    for (int t4 = 0; t4 < 4; ++t4) acco[u][t4] = __builtin_amdgcn_mfma_f32_16x16x32_bf16(vt_, a_[t4], acco[u][t4], 0, 0, 0); } }
#pragma unroll
            for (int u = 0; u < 2; ++u)
#pragma unroll
                for (int t4 = 0; t4 < 4; ++t4) *(u32x2*)(Uo + (R0 + 16 * t4 + l15) * DM + h * 256 + 16 * (2 * wave + u) + 4 * kg) = (u32x2){pk2(acco[u][t4][0], acco[u][t4][1]), pk2(acco[u][t4][2], acco[u][t4][3])};
        }
    }
}
constexpr int R_STR = 528, R_BUF64 = 64 * 528;
struct RtO { bf16x8 q[8]; u32x4 v[2]; };
struct RtS { bf16x8 k[8]; };
constexpr int L_RK = 2 * R_BUF64;
constexpr int L_RV = 4 * R_BUF64;
template <int DIR>
__device__ __forceinline__ void ret_p2b(const bf16_t* Q, const bf16_t* KT, const bf16_t* VT, bf16_t* O, LAS unsigned char* lds) {
    int tid = threadIdx.x; asm volatile("" : "+v"(tid));
    const int lane = tid & 63, wave = __builtin_amdgcn_readfirstlane(tid >> 6), role = wave >> 2, w4 = wave & 3, l15 = lane & 15, kg = lane >> 4;
    const int bx = blockIdx.x & 7, by = (blockIdx.x >> 3) & 15;
    const int dvq = by & 3, bh = bx + 8 * (by >> 3), b = bh >> 2, h = bh & 3;
    for (int i = tid; i < 2 * R_BUF64 / 4; i += 512) ((LAS unsigned*)lds)[i] = 0u;
    __syncthreads();
    const float lg = __log2f(1.0f - exp2f(-5.0f - (float)h));
    const size_t fo_ = ((size_t)b * SEQ + (lane >> 5)) * DM + h * 256 + (lane & 31) * 8;
#define RT_N(i) (DIR ? 127 - (i) : (i))
    if (role == 0) {
        const float rs = DIR ? exp2f((float)(64 - (16 * w4 + l15)) * lg) : exp2f((float)(16 * w4 + l15 + 1) * lg);
        const float g64i = exp2f(-64.f * lg);
        const bf16_t* qb = Q + fo_ + (size_t)(16 * w4) * DM;
        bf16_t* ob = O + ((size_t)b * SEQ + 16 * w4 + l15) * DM + h * 256 + 64 * dvq + 4 * kg;
        const bf16_t* vb = VT + ((size_t)b * SEQ + 16 * w4 + (lane >> 3)) * DM + h * 256 + 64 * dvq + (lane & 7) * 8;
        LAS unsigned char* vl = lds + L_RV + (16 * w4 + (lane >> 3)) * 128;
        float vs[2];
#pragma unroll
        for (int u = 0; u < 2; ++u) { const int t = 16 * w4 + 8 * u + (lane >> 3); vs[u] = exp2f((float)(DIR ? t : 63 - t) * lg); }
        unsigned otr[4];
#pragma unroll
        for (int x = 0; x < 4; ++x) otr[x] = (unsigned)(size_t)lds + L_RV + (4 * kg + (l15 >> 2)) * 128 + (((2 * x + ((l15 & 3) >> 1)) ^ (2 * (kg >> 1))) << 4) + 8 * (l15 & 1);
#define RTO_VPUT(src, par) do { _Pragma("unroll") for (int u = 0; u < 2; ++u) { const u32x4 raw = src.v[u]; u32x4 sc; \
            sc.x = pk2(bflo(raw.x) * vs[u], bfhi(raw.x) * vs[u]); sc.y = pk2(bflo(raw.y) * vs[u], bfhi(raw.y) * vs[u]); \
            sc.z = pk2(bflo(raw.z) * vs[u], bfhi(raw.z) * vs[u]); sc.w = pk2(bflo(raw.w) * vs[u], bfhi(raw.w) * vs[u]); \
            *(LAS u32x4*)(vl + (par) * 8192 + u * 1024 + (((lane & 7) ^ (2 * u)) << 4)) = sc; } } while (0)
#define RTO_LOAD(dst, n) do { const size_t c_ = (size_t)(64 * (n)) * DM; \
        _Pragma("unroll") for (int u = 0; u < 2; ++u) dst.v[u] = *(const u32x4*)(vb + c_ + (size_t)(8 * u) * DM); \
        _Pragma("unroll") for (int ks = 0; ks < 8; ++ks) dst.q[ks] = *(const bf16x8*)(qb + c_ + (size_t)(2 * ks) * DM); } while (0)
#define RTO_STEP(cur, mid, far, i) do { const int bufc = (i) & 1; \
        if ((i) + 2 < 128) RTO_LOAD(far, RT_N((i) + 2)); \
        if ((i) + 1 < 128) RTO_VPUT(mid, bufc ^ 1); \
        f32x4 acco[4]; \
        _Pragma("unroll") for (int mm = 0; mm < 4; ++mm) acco[mm] = (f32x4){0.f, 0.f, 0.f, 0.f}; \
        _Pragma("unroll") for (int ks = 0; ks < 8; ++ks) _Pragma("unroll") for (int mm = 0; mm < 4; ++mm) { \
            const bf16x8 sf = *(const LAS bf16x8*)(lds + bufc * R_BUF64 + (16 * mm + l15) * R_STR + (ks * 32 + 8 * kg) * 2); \
            acco[mm] = __builtin_amdgcn_mfma_f32_16x16x32_bf16(sf, cur.q[ks], acco[mm], 0, 0, 0); } \
        f32x4 accp[4]; \
        _Pragma("unroll") for (int si = 0; si < 4; ++si) { accp[si] = (f32x4){0.f, 0.f, 0.f, 0.f}; \
            if (DIR ? si >= w4 : si <= w4) { const int tr_ = 16 * si + l15; const int sw_ = 2 * ((tr_ >> 3) & 3); \
                const LAS unsigned char* kr_ = lds + L_RK + bufc * R_BUF64 + tr_ * R_STR; \
                _Pragma("unroll") for (int ks = 0; ks < 8; ++ks) { const bf16x8 kf_ = *(const LAS bf16x8*)(kr_ + (((4 * ks + kg) ^ sw_) << 4)); \
                    accp[si] = __builtin_amdgcn_mfma_f32_16x16x32_bf16(kf_, cur.q[ks], accp[si], 0, 0, 0); } \
                if (si == w4) { _Pragma("unroll") for (int r = 0; r < 4; ++r) { const bool keep = DIR ? (4 * kg + r >= l15) : (4 * kg + r <= l15); accp[si][r] = keep ? accp[si][r] : 0.f; } } \
                accp[si] = accp[si] * g64i; } } \
        u32x2 oo[16]; { unsigned ob_[4]; _Pragma("unroll") for (int x = 0; x < 4; ++x) ob_[x] = otr[x] + bufc * 8192; TR16_ASM(oo, ob_, 2048, 4096, 6144); } \
        _Pragma("unroll") for (int kp = 0; kp < 2; ++kp) { \
            if (DIR ? (2 * kp + 1 >= w4) : (2 * kp <= w4)) { \
                const bf16x8 pf = __builtin_bit_cast(bf16x8, (u32x4){pk2(accp[2 * kp][0], accp[2 * kp][1]), pk2(accp[2 * kp][2], accp[2 * kp][3]), pk2(accp[2 * kp + 1][0], accp[2 * kp + 1][1]), pk2(accp[2 * kp + 1][2], accp[2 * kp + 1][3])}); \
                _Pragma("unroll") for (int mm = 0; mm < 4; ++mm) { const bf16x8 vt_ = TR16_FRAG(oo, mm, kp); \
                    acco[mm] = __builtin_amdgcn_mfma_f32_16x16x32_bf16(vt_, pf, acco[mm], 0, 0, 0); } } } \
        bf16_t* op = ob + (size_t)(64 * RT_N(i)) * DM; \
        _Pragma("unroll") for (int mm = 0; mm < 4; ++mm) \
            *(u32x2*)(op + 16 * mm) = (u32x2){pk2(acco[mm][0] * rs, acco[mm][1] * rs), pk2(acco[mm][2] * rs, acco[mm][3] * rs)}; \
        __syncthreads(); } while (0)
        RtO A, B, C;
        RTO_LOAD(A, RT_N(0)); RTO_LOAD(B, RT_N(1));
        RTO_VPUT(A, 0);
        __syncthreads();
        for (int i = 0; i < 126; i += 3) { RTO_STEP(A, B, C, i); RTO_STEP(B, C, A, i + 1); RTO_STEP(C, A, B, i + 2); }
        RTO_STEP(A, B, C, 126); RTO_STEP(B, C, A, 127);
#undef RTO_STEP
#undef RTO_VPUT
#undef RTO_LOAD
    } else {
        const float cd = exp2f(64.f * lg);
        const bf16_t* kb = KT + fo_ + (size_t)(16 * w4) * DM;
        const int tq = 16 * w4 + (lane & 15), ksw = 2 * ((tq >> 3) & 3);
        LAS unsigned char* kw = lds + L_RK + tq * R_STR;
        const unsigned lds0 = (unsigned)(size_t)lds;
        unsigned vtr[4], ktr[4];
#pragma unroll
        for (int x = 0; x < 4; ++x) {
            vtr[x] = lds0 + L_RV + (8 * kg + (l15 >> 2)) * 128 + (((2 * x + ((l15 & 3) >> 1)) ^ (2 * (kg & 1))) << 4) + 8 * (l15 & 1);
            ktr[x] = lds0 + L_RK + (8 * kg + (l15 >> 2)) * R_STR + ((8 * w4 + 2 * (x ^ kg) + ((l15 & 3) >> 1)) << 4) + 8 * (l15 & 1); }
        f32x4 accS[4][4];
#pragma unroll
        for (int m = 0; m < 4; ++m)
#pragma unroll
            for (int nn = 0; nn < 4; ++nn) accS[m][nn] = (f32x4){0.f, 0.f, 0.f, 0.f};
#define RTS_LOAD(dst, n) do { const size_t c_ = (size_t)(64 * (n)) * DM; \
        _Pragma("unroll") for (int j = 0; j < 8; ++j) dst.k[j] = *(const bf16x8*)(kb + c_ + (size_t)(2 * j) * DM); } while (0)
#define RTS_KPUT(src, par) do { _Pragma("unroll") for (int j = 0; j < 8; ++j) *(LAS bf16x8*)(kw + (par) * R_BUF64 + (((4 * j + (lane >> 4)) ^ ksw) << 4)) = src.k[j]; } while (0)
#define RTS_STEP(ld, put, i) do { const int bufc = (i) & 1; \
        if ((i) + 2 < 128) RTS_LOAD(ld, RT_N((i) + 2)); \
        if ((i) + 1 < 128) RTS_KPUT(put, bufc ^ 1); \
        u32x2 ko[16], vo[16];        \
        { unsigned kb_[4], vb_[4]; _Pragma("unroll") for (int x = 0; x < 4; ++x) { kb_[x] = ktr[x] + bufc * R_BUF64; vb_[x] = vtr[x] + bufc * 8192; } \
          TR16_ASM(ko, kb_, 2112, 16896, 19008); TR16_ASM(vo, vb_, 512, 4096, 4608); } \
        _Pragma("unroll") for (int nn = 0; nn < 4; ++nn) { bf16x8 vc[2]; \
            _Pragma("unroll") for (int k2 = 0; k2 < 2; ++k2) vc[k2] = TR16_FRAG(vo, nn, k2); \
            _Pragma("unroll") for (int m = 0; m < 4; ++m) { accS[m][nn] = accS[m][nn] * cd; \
                _Pragma("unroll") for (int k2 = 0; k2 < 2; ++k2) accS[m][nn] = __builtin_amdgcn_mfma_f32_16x16x32_bf16(TR16_FRAG(ko, m, k2), vc[k2], accS[m][nn], 0, 0, 0); \
                *(LAS u32x2*)(lds + (bufc ^ 1) * R_BUF64 + (16 * nn + l15) * R_STR + (64 * w4 + 16 * m + 4 * kg) * 2) = (u32x2){pk2(accS[m][nn][0], accS[m][nn][1]), pk2(accS[m][nn][2], accS[m][nn][3])}; } } \
        __syncthreads(); } while (0)
        RtS A, B;
        RTS_LOAD(A, RT_N(0)); RTS_LOAD(B, RT_N(1));
        RTS_KPUT(A, 0);
        __syncthreads();
        for (int i = 0; i < 128; i += 2) { RTS_STEP(A, B, i); RTS_STEP(B, A, i + 1); }
#undef RTS_STEP
#undef RTS_KPUT
#undef RTS_LOAD
    }
#undef RT_N
}
template <int HD, bool TWO>
__device__ __forceinline__ void p2c_norm_gate(const bf16_t* of, const bf16_t* ob, const bf16_t* gate, const float* g, bf16_t* dst, const bf16_t* gate_lo = nullptr, int split = 0) {
    int tid = threadIdx.x; asm volatile("" : "+v"(tid));
    const int lane = tid & 63, gw = blockIdx.x * 8 + (tid >> 6), NGW = gridDim.x * 8;
    float gv[16];
#pragma unroll
    for (int j = 0; j < 16; ++j) gv[j] = g[lane * 16 + j];
    u32x4 ra[6], rb[6];
#define PC_LOAD(rs_, row) do { const size_t o_ = (size_t)(row) * DM + lane * 16; rs_[0] = *(const u32x4*)(of + o_); rs_[1] = *(const u32x4*)(of + o_ + 8); \
        if (TWO) { rs_[4] = *(const u32x4*)(ob + o_); rs_[5] = *(const u32x4*)(ob + o_ + 8); } else { rs_[4] = (u32x4){0u, 0u, 0u, 0u}; rs_[5] = rs_[4]; } \
        const bf16_t* gt_ = ((row) < split) ? gate_lo : gate;                   \
        rs_[2] = *(const u32x4*)(gt_ + o_); rs_[3] = *(const u32x4*)(gt_ + o_ + 8); } while (0)
#define PC_PROC(rs_, row) do { const size_t o = (size_t)(row) * DM + lane * 16; \
        float v[16]; const unsigned aw[8] = {rs_[0].x, rs_[0].y, rs_[0].z, rs_[0].w, rs_[1].x, rs_[1].y, rs_[1].z, rs_[1].w}; \
        const unsigned gwd[8] = {rs_[2].x, rs_[2].y, rs_[2].z, rs_[2].w, rs_[3].x, rs_[3].y, rs_[3].z, rs_[3].w}; \
        float ss = 0.f; \
        const unsigned bw[8] = {rs_[4].x, rs_[4].y, rs_[4].z, rs_[4].w, rs_[5].x, rs_[5].y, rs_[5].z, rs_[5].w}; \
        _Pragma("unroll") for (int j = 0; j < 8; ++j) { v[2 * j] = bflo(aw[j]); v[2 * j + 1] = bfhi(aw[j]); if (TWO) { v[2 * j] += bflo(bw[j]); v[2 * j + 1] += bfhi(bw[j]); } ss += v[2 * j] * v[2 * j] + v[2 * j + 1] * v[2 * j + 1]; } \
        ss = (HD == 128) ? sum_lanes8(ss) : sum_lanes16(ss); \
        const float rs = rsqrtf(ss * (1.0f / HD) + RMS_EPS); \
        unsigned ow[8]; \
        _Pragma("unroll") for (int j = 0; j < 8; ++j) ow[j] = pk2(v[2 * j] * rs * gv[2 * j] * bflo(gwd[j]), v[2 * j + 1] * rs * gv[2 * j + 1] * bfhi(gwd[j])); \
        *(u32x4*)(dst + o) = (u32x4){ow[0], ow[1], ow[2], ow[3]}; *(u32x4*)(dst + o + 8) = (u32x4){ow[4], ow[5], ow[6], ow[7]}; } while (0)
    if (gw < T_TOK) PC_LOAD(ra, gw);
    for (int row = gw; row < T_TOK; row += 2 * NGW) {
        const int r1 = row + NGW, r2 = row + 2 * NGW;
        if (r1 < T_TOK) PC_LOAD(rb, r1);
        PC_PROC(ra, row);
        if (r2 < T_TOK) PC_LOAD(ra, r2);
        if (r1 < T_TOK) PC_PROC(rb, r1);
    }
#undef PC_LOAD
#undef PC_PROC
}

constexpr int P5_XS = 2064;
constexpr int P5_XH = 0, P5_XL = 16 * P5_XS, P5_PART = 2 * 16 * P5_XS, P5_LOG = P5_PART + 8 * 16 * 48 * 4, P5_END = P5_LOG + 128 * 40 * 4;
__device__ __forceinline__ void p5_router(const Params& p, LAS unsigned char* lds) {
    int tid = threadIdx.x; asm volatile("" : "+v"(tid));
    const int lane = tid & 63, wave = __builtin_amdgcn_readfirstlane(tid >> 6), l15 = lane & 15, kg = lane >> 4;
    float* x1 = p.out; bf16_t* x1b = (bf16_t*)(p.ws + OFF_U0 + 3 * USTR);
    const float* wrt = (const float*)(p.ws + OFF_WRT);
    LAS int* ent_e = (LAS int*)(lds + LDS_MISC); LAS float* ent_w = (LAS float*)(lds + LDS_MISC + 1024);
    LAS int* ecnt = (LAS int*)(lds + LDS_MISC + 3072); LAS int* ebase = ecnt + 32;
    LAS float* PART = (LAS float*)(lds + P5_PART); LAS float* LOG = (LAS float*)(lds + P5_LOG);
    int* gcnt = (int*)(p.ws + OFF_GCNT); int* lent = (int*)(p.ws + OFF_LENT); float* lw = (float*)(p.ws + OFF_LW);
    f32x4 g4[4], b4[4];
#pragma unroll
    for (int j = 0; j < 4; ++j) { g4[j] = *(const f32x4*)(p.ln1_g + 4 * lane + 256 * j); b4[j] = *(const f32x4*)(p.ln1_b + 4 * lane + 256 * j); }
    bf16x8 wh[3][4], wlo[3][4];
#pragma unroll
    for (int nt = 0; nt < 3; ++nt)
#pragma unroll
        for (int ks = 0; ks < 4; ++ks) {
            const int o = 16 * nt + l15; f32x4 a = (f32x4){0.f, 0.f, 0.f, 0.f}, c = a;
            if (o < 36) { const float* wp = wrt + (size_t)o * 1024 + 128 * wave + 32 * ks + 8 * kg; a = *(const f32x4*)wp; c = *(const f32x4*)(wp + 4); }
            u32x4 hi; hi.x = pk2(a[0], a[1]); hi.y = pk2(a[2], a[3]); hi.z = pk2(c[0], c[1]); hi.w = pk2(c[2], c[3]);
            u32x4 lo; lo.x = pk2(a[0] - bflo(hi.x), a[1] - bfhi(hi.x)); lo.y = pk2(a[2] - bflo(hi.y), a[3] - bfhi(hi.y));
            lo.z = pk2(c[0] - bflo(hi.z), c[1] - bfhi(hi.z)); lo.w = pk2(c[2] - bflo(hi.w), c[3] - bfhi(hi.w));
            wh[nt][ks] = __builtin_bit_cast(bf16x8, hi); wlo[nt][ks] = __builtin_bit_cast(bf16x8, lo);
        }
    for (int tg = blockIdx.x; tg < T_TOK / 128; tg += gridDim.x) {
        if (tid < 32) ecnt[tid] = 0;
        f32x4 rowv[2][4];
#pragma unroll
        for (int r = 0; r < 2; ++r)
#pragma unroll
            for (int j = 0; j < 4; ++j) rowv[r][j] = ((const f32x4*)(x1 + (size_t)(tg * 128 + 2 * wave + r) * DM) + lane)[64 * j];
        for (int g = 0; g < 8; ++g) {
#pragma unroll
            for (int r = 0; r < 2; ++r) {
                const int lt = 16 * g + 2 * wave + r, token = tg * 128 + lt;
                f32x4 v[4]; float sm = 0.f;
#pragma unroll
                for (int j = 0; j < 4; ++j) { v[j] = rowv[r][j]; sm += (v[j][0] + v[j][1]) + (v[j][2] + v[j][3]); }
                const float mean = wave_sum(sm) * (1.f / DM); float s2 = 0.f;
#pragma unroll
                for (int j = 0; j < 4; ++j) { v[j] = v[j] - mean; s2 += (v[j][0] * v[j][0] + v[j][1] * v[j][1]) + (v[j][2] * v[j][2] + v[j][3] * v[j][3]); }
                const float rstd = rsqrtf(wave_sum(s2) * (1.f / DM) + LN_EPS);
#pragma unroll
                for (int j = 0; j < 4; ++j) { v[j] = v[j] * rstd * g4[j] + b4[j];
                    u32x2 hi; hi.x = pk2(v[j][0], v[j][1]); hi.y = pk2(v[j][2], v[j][3]);
                    *(u32x2*)(x1b + (size_t)token * DM + 4 * lane + 256 * j) = hi;
                    u32x2 lo; lo.x = pk2(v[j][0] - bflo(hi.x), v[j][1] - bfhi(hi.x)); lo.y = pk2(v[j][2] - bflo(hi.y), v[j][3] - bfhi(hi.y));
                    const int xo = (2 * wave + r) * P5_XS + (4 * lane + 256 * j) * 2;
                    *(LAS u32x2*)(lds + P5_XH + xo) = hi; *(LAS u32x2*)(lds + P5_XL + xo) = lo; }
            }
            if (g + 1 < 8) {
#pragma unroll
                for (int r = 0; r < 2; ++r)
#pragma unroll
                    for (int j = 0; j < 4; ++j) rowv[r][j] = ((const f32x4*)(x1 + (size_t)(tg * 128 + 16 * (g + 1) + 2 * wave + r) * DM) + lane)[64 * j];
            }
            __syncthreads();
            f32x4 acc[3];
#pragma unroll
            for (int nt = 0; nt < 3; ++nt) acc[nt] = (f32x4){0.f, 0.f, 0.f, 0.f};
#pragma unroll
            for (int ks = 0; ks < 4; ++ks) { const int ao = l15 * P5_XS + (128 * wave + 32 * ks + 8 * kg) * 2;
                const bf16x8 ah = *(const LAS bf16x8*)(lds + P5_XH + ao), al = *(const LAS bf16x8*)(lds + P5_XL + ao);
#pragma unroll
                for (int nt = 0; nt < 3; ++nt) { acc[nt] = __builtin_amdgcn_mfma_f32_16x16x32_bf16(ah, wh[nt][ks], acc[nt], 0, 0, 0);
                    acc[nt] = __builtin_amdgcn_mfma_f32_16x16x32_bf16(al, wh[nt][ks], acc[nt], 0, 0, 0);
                    acc[nt] = __builtin_amdgcn_mfma_f32_16x16x32_bf16(ah, wlo[nt][ks], acc[nt], 0, 0, 0); } }
#pragma unroll
            for (int nt = 0; nt < 3; ++nt)
#pragma unroll
                for (int j = 0; j < 4; ++j) PART[(wave * 16 + 4 * kg + j) * 48 + 16 * nt + l15] = acc[nt][j];
            __syncthreads();
            for (int e = tid; e < 16 * 36; e += 512) { const int tk = e / 36, o = e % 36; float a = (o < 4) ? p.b_group[o] : p.b_router[o - 4];
#pragma unroll
                for (int w8 = 0; w8 < 8; ++w8) a += PART[(w8 * 16 + tk) * 48 + o];
                LOG[(16 * g + tk) * 40 + o] = a; }
        }
        __syncthreads();
        {
            if (tid < 128) {
                const LAS float* lg = LOG + tid * 40; const int lt = tid;
                int grp = 0; float gmax = lg[0];
#pragma unroll
                for (int j = 1; j < 4; ++j) { if (lg[j] > gmax) { gmax = lg[j]; grp = j; } }
                float gden = 0.f;
#pragma unroll
                for (int j = 0; j < 4; ++j) gden += __expf(lg[j] - gmax);
                const float pgrp = 1.0f / gden;
                float el[8];
#pragma unroll
                for (int i = 0; i < 8; ++i) el[i] = lg[4 + grp * 8 + i];
                int i1 = 0; float m1 = el[0];
#pragma unroll
                for (int i = 1; i < 8; ++i) { if (el[i] > m1) { m1 = el[i]; i1 = i; } }
                int i2 = (i1 == 0) ? 1 : 0; float m2 = (i1 == 0) ? el[1] : el[0];
#pragma unroll
                for (int i = 1; i < 8; ++i) { if (i != i1 && el[i] > m2) { m2 = el[i]; i2 = i; } }
                const float w1 = 1.0f / (1.0f + __expf(m2 - m1)), w2 = 1.0f - w1;
                ent_e[2 * lt] = grp * 8 + i1; ent_w[2 * lt] = pgrp * w1; ent_e[2 * lt + 1] = grp * 8 + i2; ent_w[2 * lt + 1] = pgrp * w2;
            }
        }
        __syncthreads();
        int e = 0, r = 0;
        if (tid < 256) { e = ent_e[tid]; r = atomicAdd((int*)&ecnt[e], 1); }
        __syncthreads();
        if (tid < 32) ebase[tid] = atomicAdd(&gcnt[tid], ecnt[tid]);
        __syncthreads();
        if (tid < 256) { const int pos = ebase[e] + r; lent[(size_t)e * LCAP + pos] = (tg * 128 + (tid >> 1)) * 2 + (tid & 1); lw[(size_t)e * LCAP + pos] = ent_w[tid]; }
        __syncthreads();
    }
}
__device__ __forceinline__ void moe_w13(const Params& p, LAS unsigned char* lds) {
    int tid = threadIdx.x; asm volatile("" : "+v"(tid));
    const int lane = tid & 63, wave = __builtin_amdgcn_readfirstlane(tid >> 6);
    LAS float* scr = (LAS float*)(lds + wave * 16384);
    bf16_t* W13 = (bf16_t*)(p.ws + OFF_U0 + 4 * USTR);
    const int gw = blockIdx.x * 8 + wave, NGW = gridDim.x * 8;
    for (int it = gw; it < 32 * 512; it += NGW) {
        const int e = it / 512, r = it % 512;
        if (r < 256)      transpose_item(p.w1 + (size_t)e * 1024 * 512, 1024, 512, W13, e * 1024, 2, 0, scr, r, lane);
        else              transpose_item(p.w3 + (size_t)e * 1024 * 512, 1024, 512, W13, e * 1024, 2, 1, scr, r - 256, lane);
    }
}
__device__ __forceinline__ void moe_w2t(const Params& p, const LAS int* tab, LAS unsigned char* lds) {
    int tid = threadIdx.x; asm volatile("" : "+v"(tid));
    const int lane = tid & 63, wave = tid >> 6;
    LAS int* red = (LAS int*)(lds + LDS_MISC + 6144);
    const int NU = tab[64] * 4, per = (NU + 7) / 8, maxU = (per + 31) / 32, G = gridDim.x;
    int mine = 0, before = 0, total = 0;
    {
        int sl = 0;
        if (tid < G) { const int x = tid & 7, jj = tid >> 3; int px = NU - x * per; px = px < 0 ? 0 : (px > per ? per : px);
            const int u = px > jj ? (px - jj + 31) / 32 : 0; sl = maxU - u; }
        const float fb = wave_sum((tid < (int)blockIdx.x) ? (float)sl : 0.f), ft = wave_sum((float)sl), fm = wave_sum((tid == (int)blockIdx.x) ? (float)sl : 0.f);
        if (lane == 0) { red[wave] = (int)fb; red[8 + wave] = (int)ft; red[16 + wave] = (int)fm; }
        __syncthreads();
#pragma unroll
        for (int w = 0; w < 8; ++w) { before += red[w]; total += red[8 + w]; mine += red[16 + w]; }
    }
    if (total == 0) { mine = 1; before = blockIdx.x; total = G; }
    const int i0 = (int)((long)8192 * before / total), i1 = (int)((long)8192 * (before + mine) / total);
    LAS float* scr = (LAS float*)(lds + wave * 16384);
    bf16_t* W2T = (bf16_t*)(p.ws + OFF_U0 + 5 * USTR);
    for (int it = i0 + wave; it < i1; it += 8) { const int e = it >> 8, r = it & 255;
        transpose_item(p.w2 + (size_t)e * 512 * 1024, 512, 1024, W2T, e * 1024, 1, 0, scr, r, lane); }
}
__device__ __forceinline__ void moe_tables(const Params& p, LAS int* tab) {
    if (threadIdx.x == 0) {
        const int* gcnt = (const int*)(p.ws + OFF_GCNT); int acc = 0;
        for (int e = 0; e < 32; ++e) { const int c = gcnt[e]; tab[e] = c; tab[32 + e] = acc; acc += (c + 255) >> 8; }
        tab[64] = acc;
    }
    __syncthreads();
}
__device__ __forceinline__ void p8_final(const Params& p) {
    int tid = threadIdx.x; asm volatile("" : "+v"(tid));
    const int lane = tid & 63, gw = blockIdx.x * 8 + (tid >> 6), NGW = gridDim.x * 8;
    const bf16_t* Y0 = (const bf16_t*)(p.ws + OFF_U0 + 2 * USTR); const bf16_t* Y1 = (const bf16_t*)(p.ws + OFF_XB);
    const bf16_t* X1B = (const bf16_t*)(p.ws + OFF_U0 + 3 * USTR);
    f32x4 g4[4], b4[4];
#pragma unroll
    for (int j = 0; j < 4; ++j) { g4[j] = *(const f32x4*)(p.ln2_g + 4 * lane + 256 * j); b4[j] = *(const f32x4*)(p.ln2_b + 4 * lane + 256 * j); }
    f32x4 xa[4], xb_[4]; u32x2 ya0[4], ya1[4], yb0[4], yb1[4];
#define P8_LOAD(xs, y0s, y1s, row) do { \
        _Pragma("unroll") for (int j = 0; j < 4; ++j) { const u32x2 xw_ = *(const u32x2*)(X1B + (size_t)(row) * DM + 4 * lane + 256 * j); xs[j] = (f32x4){bflo(xw_.x), bfhi(xw_.x), bflo(xw_.y), bfhi(xw_.y)}; y0s[j] = *(const u32x2*)(Y0 + (size_t)(row) * DM + 4 * lane + 256 * j); y1s[j] = *(const u32x2*)(Y1 + (size_t)(row) * DM + 4 * lane + 256 * j); } } while (0)
#define P8_PROC(xs, y0s, y1s, row) do { f32x4* pr = (f32x4*)(p.out + (size_t)(row) * DM) + lane; f32x4 v[4]; float s = 0.f; \
        _Pragma("unroll") for (int j = 0; j < 4; ++j) { const u32x2 a = y0s[j], b = y1s[j]; \
            const f32x4 y = (f32x4){bflo(a.x) + bflo(b.x), bfhi(a.x) + bfhi(b.x), bflo(a.y) + bflo(b.y), bfhi(a.y) + bfhi(b.y)}; \
            v[j] = xs[j] * ALPHA + y; s += (v[j][0] + v[j][1]) + (v[j][2] + v[j][3]); } \
        const float mean = wave_sum(s) * (1.f / DM); float s2 = 0.f; \
        _Pragma("unroll") for (int j = 0; j < 4; ++j) { v[j] = v[j] - mean; s2 += (v[j][0] * v[j][0] + v[j][1] * v[j][1]) + (v[j][2] * v[j][2] + v[j][3] * v[j][3]); } \
        const float rstd = rsqrtf(wave_sum(s2) * (1.f / DM) + LN_EPS); \
        _Pragma("unroll") for (int j = 0; j < 4; ++j) pr[64 * j] = v[j] * rstd * g4[j] + b4[j]; } while (0)
    if (gw < T_TOK) P8_LOAD(xa, ya0, ya1, gw);
    for (int row = gw; row < T_TOK; row += 2 * NGW) {
        const int r1 = row + NGW, r2 = row + 2 * NGW;
        if (r1 < T_TOK) P8_LOAD(xb_, yb0, yb1, r1);
        P8_PROC(xa, ya0, ya1, row);
        if (r2 < T_TOK) P8_LOAD(xa, ya0, ya1, r2);
        if (r1 < T_TOK) P8_PROC(xb_, yb0, yb1, r1);
    }
#undef P8_LOAD
#undef P8_PROC
}

typedef const __attribute__((address_space(4))) Params* KPtr;
#if defined(__HIP_DEVICE_COMPILE__)
__device__ __forceinline__ KPtr KPP() { KPtr k = (KPtr)__builtin_amdgcn_kernarg_segment_ptr(); asm volatile("" : "+s"(k)); return k; }
#else
__device__ __forceinline__ KPtr KPP() { return (KPtr)0; }
#endif
#define KP() (*KPP())
__device__ __forceinline__ Params load_params() {
    KPtr k = KPP(); Params p;
    p.x = k->x; p.pos = k->pos; p.w_in = k->w_in; p.lb_logits = k->lb_logits; p.hg_norm_g = k->hg_norm_g; p.ret_norm_g = k->ret_norm_g;
    p.w_bh = k->w_bh; p.w_br = k->w_br; p.w_out = k->w_out; p.ln1_g = k->ln1_g; p.ln1_b = k->ln1_b; p.w_group = k->w_group; p.b_group = k->b_group;
    p.w_router = k->w_router; p.b_router = k->b_router; p.w1 = k->w1; p.w3 = k->w3; p.w2 = k->w2; p.ln2_g = k->ln2_g; p.ln2_b = k->ln2_b; p.out = k->out; p.ws = k->ws;
    return p;
}
#define WSP(off) (KP().ws + (size_t)(off))
#define UP(k) ((bf16_t*)(KP().ws + OFF_U0 + (size_t)(k) * USTR))
__device__ __forceinline__ void grid_bar(LAS unsigned char* lds) {
    XcdBarrier b; b.bar = (unsigned*)WSP(OFF_CTL); b.x = xb_xcc_id(); b.st = (volatile LAS unsigned*)(lds + LDS_XB);
    xcd_barrier(b);
}
__global__ void __launch_bounds__(512, 2) mega(Params p_unused) {
    extern __shared__ __attribute__((aligned(16))) unsigned char lds_raw[];
    LAS unsigned char* lds = (LAS unsigned char*)lds_raw;
    cg::grid_group grid = cg::this_grid();
    {
        volatile LAS unsigned* xbw = (volatile LAS unsigned*)(lds + LDS_XB);
        if (threadIdx.x < 16) xbw[threadIdx.x] = 0u;
        __syncthreads();
        (void)xcd_barrier_post((unsigned*)WSP(OFF_CTL), xbw);
    }
    { const Params p = load_params(); p0_prep(p, lds); }
    grid_bar(lds);
    if (KP().ws == nullptr) grid.sync();
    {
        SchedProj S; S.to.init(T_TOK, 4096); S.A = (const char*)WSP(OFF_XB); S.Bt = (const char*)WSP(OFF_WIN); S.col0 = 0; S.G = gridDim.x; S.c = blockIdx.x;
        S.kinds = (unsigned)ACT_SILU | (ACT_LOGF << 4) | (ACT_LOGF << 8) | (ACT_NONE << 12);
        EpiProj E{UP(0), (bf16_t*)KP().out, (const float*)WSP(OFF_LB), KP().pos, (const double*)WSP(OFF_INV), (bf16_t*)KP().out + TD, (bf16_t*)WSP(OFF_RG2), UP(4)};
        gemm_phase(lds, 1024, S, E);
    }
    grid_bar(lds);
    if (blockIdx.x < 128) {
        if ((blockIdx.x >> 4) & 1) hgrn_fused<1>(UP(0), UP(2), UP(3), (bf16_t*)KP().out + TD, lds);
        else                       hgrn_fused<0>(UP(0), UP(1), UP(3), UP(5), lds);
    }
    if (blockIdx.x >= 128 || gridDim.x < 256) {
        SchedGates2 S; S.to.init(T_TOK, 1024); S.A = (const char*)WSP(OFF_XB); S.Bt = (const char*)WSP(OFF_WIN);
        S.G = (gridDim.x < 256) ? gridDim.x : gridDim.x - 128; S.c = (gridDim.x < 256) ? blockIdx.x : blockIdx.x - 128;
        EpiProj E{UP(0), (bf16_t*)KP().out, (const float*)WSP(OFF_LB), KP().pos, (const double*)WSP(OFF_INV), (bf16_t*)KP().out + TD, (bf16_t*)WSP(OFF_RG2), UP(4)};
        gemm_phase(lds, 1024, S, E);
    }
    grid_bar(lds);
    p2c_norm_gate<128, true>(UP(5), (const bf16_t*)KP().out + TD, (const bf16_t*)KP().out, KP().hg_norm_g, (bf16_t*)KP().out);
    {
        SchedProjR S; S.to.init(T_TOK, 3072); S.A = (const char*)WSP(OFF_XB); S.Bt = (const char*)WSP(OFF_WIN); S.G = gridDim.x; S.c = blockIdx.x;
        EpiProj E{UP(0), (bf16_t*)KP().out, (const float*)WSP(OFF_LB), KP().pos, (const double*)WSP(OFF_INV), (bf16_t*)KP().out + TD, (bf16_t*)WSP(OFF_RG2), UP(4)};
        gemm_phase(lds, 1024, S, E);
    }
    grid_bar(lds);
    if (blockIdx.x < 128) {
        if ((blockIdx.x >> 5) & 1) ret_p2b<1>(UP(0), UP(1), UP(2), UP(3), lds);
        else                       ret_p2b<0>(UP(0), UP(1), UP(2), UP(5), lds);
    }
    if (blockIdx.x >= 128 || gridDim.x < 256) {
        SchedRetHelp S; S.to.init(T_TOK, 1024); S.A = (const char*)WSP(OFF_XB); S.Bt = (const char*)WSP(OFF_WIN); S.ohg = (const char*)KP().out; S.wbh = (const char*)WSP(OFF_WBH);
        S.G = (gridDim.x < 256) ? gridDim.x : gridDim.x - 128; S.c = (gridDim.x < 256) ? blockIdx.x : blockIdx.x - 128;
        EpiRetHelp E{EpiProj{UP(0), (bf16_t*)KP().out, (const float*)WSP(OFF_LB), KP().pos, (const double*)WSP(OFF_INV), (bf16_t*)KP().out + TD, (bf16_t*)WSP(OFF_RG2), UP(4)},
                     EpiMix{UP(4), UP(2), UP(4), UP(0)}};
        gemm_phase(lds, 1024, S, E);
    }
    grid_bar(lds);
    p2c_norm_gate<256, true>(UP(5), UP(3), (const bf16_t*)KP().out + TD, KP().ret_norm_g, (bf16_t*)KP().out + TD);
    split_arrive((unsigned*)WSP(OFF_CTL), (volatile LAS unsigned*)(lds + LDS_XB), 0);
    {
        SchedMix S; S.ctl = (unsigned*)WSP(OFF_CTL); S.nx = ((volatile LAS unsigned*)(lds + LDS_XB))[1]; S.to.init(T_TOK, 1024); S.xb = (const char*)WSP(OFF_XB); S.ohg = (const char*)KP().out; S.oret = (const char*)((bf16_t*)KP().out + TD); S.win = (const char*)WSP(OFF_WIN);
        S.wbh = (const char*)WSP(OFF_WBH); S.wbr = (const char*)WSP(OFF_WBR); S.G = gridDim.x; S.c = blockIdx.x;
        EpiMix E{UP(4), UP(2), UP(4), UP(0)};
        gemm_phase(lds, 1024, S, E);
    }
    grid_bar(lds);
    {
        SchedPlain S; S.to.init(T_TOK, 1024); S.A = (const char*)UP(0); S.Bt = (const char*)WSP(OFF_WO); S.G = gridDim.x; S.c = blockIdx.x; S.K = 1024;
        EpiPre1 E{KP().x, KP().out};
        gemm_phase(lds, 1024, S, E);
    }
    split_arrive((unsigned*)WSP(OFF_CTL), (volatile LAS unsigned*)(lds + LDS_XB), 1);
    { const Params p = load_params(); moe_w13(p, lds); }
    split_wait_wave((unsigned*)WSP(OFF_CTL), ((volatile LAS unsigned*)(lds + LDS_XB))[1], 1);
    __syncthreads();
    { const Params p = load_params(); p5_router(p, lds); }
    grid_bar(lds);
    LAS int* tab = (LAS int*)(lds + LDS_MISC);
    { const Params p = load_params(); moe_tables(p, tab); }
    {
        SchedMoe1 S; S.tab = tab; S.G = gridDim.x; S.c = blockIdx.x; S.init_counts(); S.Abase = (const char*)UP(3); S.Bbase = (const char*)UP(4); S.b_estride = (size_t)1024 * 1024 * 2; S.K = 1024; S.gather = true;
        S.lent = (const int*)WSP(OFF_LENT);
        EpiMoe1 E{UP(0)};
        gemm_phase(lds, 1024, S, E);
    }
    { const Params p = load_params(); moe_w2t(p, tab, lds); }
    grid_bar(lds);
    {
        SchedMoe2 S; S.tab = tab; S.G = gridDim.x; S.c = blockIdx.x; S.init_counts(); S.Abase = (const char*)UP(0); S.Bbase = (const char*)UP(5); S.b_estride = (size_t)1024 * 512 * 2; S.K = 512; S.gather = false;
        S.lent = (const int*)WSP(OFF_LENT);
        EpiMoe2 E{UP(2), (long)((bf16_t*)WSP(OFF_XB) - UP(2)), (const int*)WSP(OFF_LENT), (const float*)WSP(OFF_LW), tab};
        gemm_phase(lds, 512, S, E);
    }
    grid_bar(lds);
    { const Params p = load_params(); p8_final(p); }
}

extern "C" void kernel_launch(void* const* d_in, const int* in_sizes, int n_in, void* d_out, int out_size, void* d_ws, size_t ws_size, hipStream_t stream) {
    static int grid_blocks = 0;
    if (!grid_blocks) {
        int dev = 0, cus = 0, per_cu = 0;
        (void)hipGetDevice(&dev);
        (void)hipDeviceGetAttribute(&cus, hipDeviceAttributeMultiprocessorCount, dev);
        (void)hipFuncSetAttribute((const void*)mega, hipFuncAttributeMaxDynamicSharedMemorySize, LDS_BYTES);
        (void)hipOccupancyMaxActiveBlocksPerMultiprocessor(&per_cu, (const void*)mega, 512, LDS_BYTES);
        if (per_cu < 1) per_cu = 1;
        grid_blocks = cus;
        fprintf(stderr, "grid %d (cus %d per_cu %d) ws %zu\n", grid_blocks, cus, per_cu, ws_size);
    }
    (void)hipMemsetAsync(d_ws, 0, CTL_ZERO_BYTES, stream);
    Params p{};
    p.x = (const float*)d_in[0]; p.pos = (const int*)d_in[1]; p.w_in = (const float*)d_in[2]; p.lb_logits = (const float*)d_in[3];
    p.hg_norm_g = (const float*)d_in[4]; p.ret_norm_g = (const float*)d_in[5]; p.w_bh = (const float*)d_in[6]; p.w_br = (const float*)d_in[7];
    p.w_out = (const float*)d_in[8]; p.ln1_g = (const float*)d_in[9]; p.ln1_b = (const float*)d_in[10]; p.w_group = (const float*)d_in[11];
    p.b_group = (const float*)d_in[12]; p.w_router = (const float*)d_in[13]; p.b_router = (const float*)d_in[14]; p.w1 = (const float*)d_in[15];
    p.w3 = (const float*)d_in[16]; p.w2 = (const float*)d_in[17]; p.ln2_g = (const float*)d_in[18]; p.ln2_b = (const float*)d_in[19];
    p.out = (float*)d_out; p.ws = (unsigned char*)d_ws;
    void* args[] = {&p};
    hipError_t e = hipLaunchCooperativeKernel((const void*)mega, dim3(grid_blocks), dim3(512), args, LDS_BYTES, stream);
    if (e != hipSuccess) fprintf(stderr, "cooperative launch failed: %s (grid %d)\n", hipGetErrorString(e), grid_blocks);
}
```

```cpp
#include <hip/hip_runtime.h>
#include <hip/hip_cooperative_groups.h>
#include <cstdio>
#include <cstdint>
namespace cg = cooperative_groups;
#define LAS __attribute__((address_space(3)))
typedef unsigned short bf16_t;
typedef short bf16x8 __attribute__((ext_vector_type(8)));
typedef float f32x4 __attribute__((ext_vector_type(4)));
typedef unsigned u32x4 __attribute__((ext_vector_type(4)));
typedef unsigned u32x2 __attribute__((ext_vector_type(2)));

constexpr int T_TOK = 32768, DM = 1024, SEQ = 8192;
constexpr size_t MiB = 1u << 20;
constexpr size_t TD = (size_t)T_TOK * DM;
constexpr float ALPHA = 1.189207115002721f;
constexpr float LN_EPS = 1e-5f, RMS_EPS = 1e-6f;
constexpr size_t OFF_CTL = 0;
constexpr size_t OFF_GCNT = 16384;
constexpr size_t OFF_LB = 64 * 1024;
constexpr size_t OFF_INV = 80 * 1024;
constexpr size_t OFF_WRT = 128 * 1024;
constexpr size_t OFF_WIN = 1 * MiB;
constexpr size_t OFF_WBH = 23 * MiB, OFF_WBR = 25 * MiB, OFF_WO = 27 * MiB;
constexpr size_t OFF_U0 = 32 * MiB;
constexpr size_t USZ = 64 * MiB;
constexpr size_t USTR = USZ + 152320;
constexpr size_t OFF_XB = OFF_U0 + 6 * USTR;
constexpr size_t OFF_SP = OFF_XB + USTR;
static_assert(OFF_SP + 28 * MiB <= 512 * MiB, "workspace map exceeds the contract's 512 MiB");
constexpr size_t OFF_LENT = OFF_SP, OFF_LW = OFF_SP + 4 * MiB;
constexpr size_t OFF_RG2 = OFF_SP + 12 * MiB;
constexpr int RG2_PANELS = 32, RG2_ROWS = RG2_PANELS * 256;
constexpr int LCAP = 32768;
constexpr int CTL_ZERO_BYTES = 32768;
constexpr int LDS_BYTES = 152 * 1024;
constexpr int LDS_MISC = 144 * 1024;
constexpr int LDS_XB = LDS_BYTES - 64;

typedef __bf16 bf16v2_t __attribute__((ext_vector_type(2)));
typedef float f32v2_t __attribute__((ext_vector_type(2)));
__device__ __forceinline__ unsigned pk2(float lo, float hi) { const f32v2_t v = {lo, hi}; const bf16v2_t b = __builtin_convertvector(v, bf16v2_t); return __builtin_bit_cast(unsigned, b); }
__device__ __forceinline__ float bflo(unsigned w) { return __uint_as_float(w << 16); }
__device__ __forceinline__ float bfhi(unsigned w) { return __uint_as_float(w & 0xffff0000u); }
__device__ __forceinline__ float bf2f(bf16_t h) { return __uint_as_float(((unsigned)h) << 16); }
__device__ __forceinline__ float sigmoidf_(float x) { return __builtin_amdgcn_rcpf(1.0f + __expf(-x)); }
__device__ __forceinline__ float siluf_(float x) { return x * __builtin_amdgcn_rcpf(1.0f + __expf(-x)); }
template <int CTRL> __device__ __forceinline__ float dpp_f(float v) { return __builtin_bit_cast(float, __builtin_amdgcn_update_dpp(0, __builtin_bit_cast(int, v), CTRL, 0xF, 0xF, false)); }
__device__ __forceinline__ float sum_lanes8(float v) { v += dpp_f<0xB1>(v); v += dpp_f<0x4E>(v); v += dpp_f<0x141>(v); return v; }
__device__ __forceinline__ float sum_lanes16(float v) { v = sum_lanes8(v); v += dpp_f<0x140>(v); return v; }
__device__ __forceinline__ float wave_sum(float v) {
    const int r = __builtin_bit_cast(int, sum_lanes16(v));
    const float a = __builtin_bit_cast(float, __builtin_amdgcn_readlane(r, 0)), b = __builtin_bit_cast(float, __builtin_amdgcn_readlane(r, 16));
    const float c = __builtin_bit_cast(float, __builtin_amdgcn_readlane(r, 32)), d = __builtin_bit_cast(float, __builtin_amdgcn_readlane(r, 48));
    return (a + b) + (c + d);
}

#define XB_TMO      128
#define XB_XCNT(j)  (256  + 64 * (j))
#define XB_XSUB(j)  (1280 + 64 * (j))
#define XB_XGEN(j)  (2304 + 64 * (j))
#define XB_TOP      3328
#define XB_TOPGEN   3392
#define XCD_BAR_WORDS 3456
#define XB_SPIN_CAP (1u << 20)
__device__ __forceinline__ unsigned xb_ld(unsigned* p)              { return __hip_atomic_load(p, __ATOMIC_RELAXED, __HIP_MEMORY_SCOPE_AGENT); }
__device__ __forceinline__ unsigned xb_add(unsigned* p, unsigned v) { return __hip_atomic_fetch_add(p, v, __ATOMIC_RELAXED, __HIP_MEMORY_SCOPE_AGENT); }
__device__ __forceinline__ unsigned xb_xcc_id() { return (unsigned)__builtin_amdgcn_s_getreg((3 << 11) | 20) & 0xFu; }
#define XB_SPIN(cond, bar) do { unsigned _sp = 0; while (cond) { __builtin_amdgcn_s_sleep(1); \
    if ((++_sp & 255u) == 0u) { if (xb_ld(&(bar)[XB_TMO])) break; if (_sp > XB_SPIN_CAP) { atomicAdd(&(bar)[XB_TMO], 1u); break; } } } } while (0)
struct XcdBarrier { unsigned* bar; unsigned x; volatile LAS unsigned* st; };
__device__ __forceinline__ XcdBarrier xcd_barrier_post(unsigned* bar, volatile LAS unsigned* st) {
    XcdBarrier b; b.bar = bar; b.x = xb_xcc_id(); b.st = st;
    if (threadIdx.x == 0) (void)xb_add(&bar[XB_XCNT(b.x)], 1u);
    return b;
}
__device__ __forceinline__ void xcd_barrier_complete(unsigned* bar, unsigned x, unsigned& nloc, unsigned& nx) {
    const unsigned G = gridDim.x * gridDim.y * gridDim.z;
    unsigned sum, cnt, mine, sp = 0u;
    for (;;) {
        sum = 0u; cnt = 0u; mine = 0u;
#pragma unroll
        for (unsigned j = 0; j < 16; ++j) { const unsigned c = xb_ld(&bar[XB_XCNT(j)]); sum += c; cnt += (c > 0u) ? 1u : 0u; mine = (j == x) ? c : mine; }
        if (sum == G) break;
        __builtin_amdgcn_s_sleep(1);
        if ((++sp & 255u) == 0u) { if (xb_ld(&bar[XB_TMO])) break; if (sp > XB_SPIN_CAP) { atomicAdd(&bar[XB_TMO], 1u); break; } }
    }
    nloc = mine > 0u ? mine : 1u; nx = cnt > 0u ? cnt : 1u;
}
__device__ __forceinline__ void xcd_barrier(const XcdBarrier& b) {
    asm volatile("s_waitcnt vmcnt(0)" ::: "memory");
    __syncthreads();
    if (threadIdx.x == 0) {
        unsigned* bar = b.bar;
        __builtin_amdgcn_s_waitcnt(0);
        unsigned nloc = b.st[0], nx = b.st[1];
        if (nloc == 0u) { xcd_barrier_complete(bar, b.x, nloc, nx); b.st[0] = nloc; b.st[1] = nx; }
        const unsigned old = xb_add(&bar[XB_XSUB(b.x)], 1u);
        const unsigned gen = old / nloc;
        if (old + 1u == (gen + 1u) * nloc) {
            __builtin_amdgcn_fence(__ATOMIC_RELEASE, "agent");
            asm volatile("s_waitcnt vmcnt(0)" ::: "memory");
            const unsigned og = xb_add(&bar[XB_TOP], 1u);
            const unsigned tg = og / nx;
            if (og + 1u == (tg + 1u) * nx) xb_add(&bar[XB_TOPGEN], 1u);
            else XB_SPIN(xb_ld(&bar[XB_TOPGEN]) == tg, bar);
            __builtin_amdgcn_fence(__ATOMIC_ACQUIRE, "agent");
            xb_add(&bar[XB_XGEN(b.x)], 1u);
            asm volatile("s_waitcnt vmcnt(0)" ::: "memory");
        } else {
            XB_SPIN(xb_ld(&bar[XB_XGEN(b.x)]) == gen, bar);
            __builtin_amdgcn_fence(__ATOMIC_ACQUIRE, "agent");
            asm volatile("s_waitcnt vmcnt(0)" ::: "memory");
        }
    }
    __syncthreads();
}

constexpr int BM = 256, BK = 64, HALF = 128, HTB = HALF * BK * 2, NXCD = 8, WGM = 4;
__device__ __forceinline__ int lds_byte(int r, int c) { const int st = (r >> 4) * 2 + (c >> 5), rr = r & 15, cc = c & 31, ob = rr * 64 + cc * 2; return st * 1024 + (ob ^ (((ob >> 9) & 1) << 5)); }
__device__ __forceinline__ void stage_rc(int b, int& R, int& C) { const int st = b / 1024, sb = b % 1024, swz = sb ^ (((sb >> 9) & 1) << 5); R = (st >> 1) * 16 + swz / 64; C = (st & 1) * 32 + (swz % 64) / 2; }
__device__ __forceinline__ int perm32(int rho) { const int n = rho >> 4, i = rho & 15; return 8 * (i >> 2) + 4 * n + (i & 3); }

struct Unit { const char* A; const char* B; int pm, pn, kind, aux; };
struct TileOrder {
    int nM, nN, nwg;
    __device__ __forceinline__ void init(int M, int N) { nM = M / BM; nN = N / BM; nwg = nM * nN; }
    __device__ __forceinline__ bool get(long L, int& pm, int& pn) const {
        if (L >= nwg) return false;
        int wgid = (int)L; { const int q = nwg / NXCD, r = nwg % NXCD, xcd = wgid % NXCD, off = wgid / NXCD; wgid = (xcd < r ? xcd * (q + 1) : r * (q + 1) + (xcd - r) * q) + off; }
        const int nig = WGM * nN, gid = wgid / nig, fm = gid * WGM, gsz = (nM - fm) < WGM ? (nM - fm) : WGM;
        pm = fm + ((wgid % nig) % gsz); pn = (wgid % nig) / gsz; return true;
    }
};

template <class Epi, class Sched>
__device__ __forceinline__ void gemm_phase(LAS unsigned char* lds, const int K, const Sched& S, const Epi& E) {
    int tid = threadIdx.x; asm volatile("" : "+v"(tid));
    const int wid = __builtin_amdgcn_readfirstlane(tid >> 6), lane = tid & 63, wr = wid >> 2, wc = wid & 3, fr = lane & 15, fq = lane >> 4;
    const int nt = K / BK;
    int sR[2], sC[2]; unsigned voffB[2];
#pragma unroll
    for (int i = 0; i < 2; ++i) { stage_rc(tid * 16 + i * 8192, sR[i], sC[i]); const int Rb = (sR[i] & ~31) + perm32(sR[i] & 31); voffB[i] = (unsigned)(Rb * K + sC[i]) * 2u; }
    const size_t kstep = (size_t)(BK * 2);
    const size_t hstep = (size_t)HALF * K * 2;
    const unsigned ldsw = (unsigned)wid * 1024u;
    const int aoff = lds_byte(wr * 64 + fr, fq * 8), boff = lds_byte(wc * 32 + fr, fq * 8);
#define PG8_SA(b, h) (((b) * 2 + (h)) * HTB)
#define PG8_SB(b, h) ((4 + (b) * 2 + (h)) * HTB)
#define PG8_STAGE(bufoff, gbase, voff) do { _Pragma("unroll") for (int _i = 0; _i < 2; ++_i) \
        __builtin_amdgcn_global_load_lds((const unsigned*)((const char*)(gbase) + (voff)[_i]), (LAS unsigned*)(lds + (bufoff) + ldsw + _i * 8192), 16, 0, 0); } while (0)
#define PG8_LDA(dst, b, h) do { _Pragma("unroll") for (int m = 0; m < 4; ++m) _Pragma("unroll") for (int k = 0; k < 2; ++k) dst[m][k] = *(const LAS bf16x8*)(lds + PG8_SA(b, h) + aoff + m * 2048 + k * 1024); } while (0)
#define PG8_LDB(dst, b, h) do { _Pragma("unroll") for (int n = 0; n < 2; ++n) _Pragma("unroll") for (int k = 0; k < 2; ++k) dst[n][k] = *(const LAS bf16x8*)(lds + PG8_SB(b, h) + boff + n * 2048 + k * 1024); } while (0)
#define PG8_MMA(ai, bj, At, Bt) do { __builtin_amdgcn_s_setprio(1); _Pragma("unroll") for (int m = 0; m < 4; ++m) _Pragma("unroll") for (int n = 0; n < 2; ++n) _Pragma("unroll") for (int k = 0; k < 2; ++k) \
        acc[ai][bj][m][n] = __builtin_amdgcn_mfma_f32_16x16x32_bf16(Bt[n][k], At[m][k], acc[ai][bj][m][n], 0, 0, 0); __builtin_amdgcn_s_setprio(0); } while (0)
#define PG8_WAIT_V(n) asm volatile("s_waitcnt vmcnt(" #n ")" ::: "memory")
#define PG8_WAIT_L(n) asm volatile("s_waitcnt lgkmcnt(" #n ")" ::: "memory")
#define PG8_BAR __builtin_amdgcn_s_barrier()
#define PG8_SCHED __builtin_amdgcn_sched_barrier(0)
    Unit cur, nxt; int ui = 0;
    if (!S.next(0, cur)) return;
    f32x4 acc[2][2][4][2];
#pragma unroll
    for (int a = 0; a < 2; ++a)
#pragma unroll
        for (int b = 0; b < 2; ++b)
#pragma unroll
            for (int m = 0; m < 4; ++m)
#pragma unroll
                for (int n = 0; n < 2; ++n) acc[a][b][m][n] = (f32x4){0.f, 0.f, 0.f, 0.f};
    bf16x8 At[4][2], B0[2][2], B1[2][2];
    unsigned voffA[2];
#pragma unroll
    for (int i = 0; i < 2; ++i) voffA[i] = (unsigned)(sR[i] * K + sC[i]) * 2u;
    LAS int* tokb = (LAS int*)(lds + LDS_MISC + 4096);
#define PG8_GETOFF(dst, par, half) do { if constexpr (Sched::GATHER) { _Pragma("unroll") for (int _i = 0; _i < 2; ++_i) { const int _t = tokb[(par) * 256 + (half) * 128 + sR[_i]]; dst[_i] = (unsigned)(_t * K + sC[_i]) * 2u; } } \
        else { dst[0] = voffA[0]; dst[1] = voffA[1]; } } while (0)
    if constexpr (Sched::GATHER) { if (tid < 256) tokb[tid] = S.row_id(cur, tid); PG8_WAIT_L(0); PG8_BAR; }
    const char* cA0 = cur.A; const char* cA1 = cur.A + (Sched::GATHER ? (size_t)0 : hstep); const char* cB = cur.B;
    { unsigned o0[2], o1[2]; PG8_GETOFF(o0, 0, 0); PG8_GETOFF(o1, 0, 1);
    PG8_STAGE(PG8_SB(0, 0), cB, voffB); PG8_STAGE(PG8_SB(0, 1), cB + hstep, voffB); PG8_STAGE(PG8_SA(0, 0), cA0, o0); PG8_STAGE(PG8_SA(0, 1), cA1, o1);
    if (wr == 1) PG8_BAR;
    PG8_WAIT_V(2); PG8_BAR;
    PG8_STAGE(PG8_SB(1, 0), cB + kstep, voffB); PG8_STAGE(PG8_SA(1, 0), cA0 + kstep, o0); PG8_STAGE(PG8_SB(1, 1), cB + hstep + kstep, voffB);
    PG8_WAIT_V(6); PG8_BAR; }
    for (;;) {
        const bool has_next = S.next(ui + 1, nxt);
        const char* nA0 = cA0; const char* nA1 = cA1; const char* nB = cB;
        const int par = ui & 1;
        if (has_next) { nA0 = nxt.A; nA1 = nxt.A + (Sched::GATHER ? (size_t)0 : hstep); nB = nxt.B;
            if constexpr (Sched::GATHER) { if (tid < 256) tokb[(par ^ 1) * 256 + tid] = S.row_id(nxt, tid); } }
        for (int t = 0; t < nt; t += 2) {
            const bool last = (t == nt - 2);
            const char* a1_1 = cA1 + (size_t)(t + 1) * kstep;
            const char* a2_0 = last ? nA0 : cA0 + (size_t)(t + 2) * kstep; const char* a2_1 = last ? nA1 : cA1 + (size_t)(t + 2) * kstep; const char* b2 = last ? nB : cB + (size_t)(t + 2) * kstep;
            const char* a3_0 = a2_0 + kstep; const char* b3 = b2 + kstep;
            unsigned cO1[2], o2_0[2], o2_1[2];
            const int p2 = (last && has_next) ? (par ^ 1) : par;
            PG8_GETOFF(cO1, par, 1); PG8_GETOFF(o2_0, p2, 0); PG8_GETOFF(o2_1, p2, 1);
            PG8_LDB(B0, 0, 0); PG8_LDB(B1, 0, 1); PG8_SCHED; PG8_LDA(At, 0, 0); PG8_STAGE(PG8_SA(1, 1), a1_1, cO1);
            PG8_WAIT_V(8); PG8_WAIT_L(0); PG8_BAR; PG8_MMA(0, 0, At, B0); PG8_MMA(0, 1, At, B1); PG8_BAR; PG8_SCHED;
            PG8_LDA(At, 0, 1); PG8_STAGE(PG8_SB(0, 0), b2, voffB); PG8_STAGE(PG8_SB(0, 1), b2 + hstep, voffB); PG8_STAGE(PG8_SA(0, 0), a2_0, o2_0);
            PG8_WAIT_V(8); PG8_WAIT_L(0); PG8_BAR; PG8_MMA(1, 0, At, B0); PG8_MMA(1, 1, At, B1); PG8_BAR; PG8_SCHED;
            PG8_LDB(B0, 1, 0); PG8_LDB(B1, 1, 1); PG8_SCHED; PG8_LDA(At, 1, 0); PG8_STAGE(PG8_SA(0, 1), a2_1, o2_1);
            PG8_WAIT_V(8); PG8_WAIT_L(0); PG8_BAR; PG8_MMA(0, 0, At, B0); PG8_MMA(0, 1, At, B1); PG8_BAR; PG8_SCHED;
            PG8_LDA(At, 1, 1); PG8_STAGE(PG8_SB(1, 0), b3, voffB); PG8_STAGE(PG8_SB(1, 1), b3 + hstep, voffB); PG8_STAGE(PG8_SA(1, 0), a3_0, o2_0);
            PG8_WAIT_V(8); PG8_WAIT_L(0); PG8_BAR; PG8_MMA(1, 0, At, B0); PG8_MMA(1, 1, At, B1); PG8_BAR; PG8_SCHED;
        }
        if (wr == 0) PG8_BAR;
        E(acc, cur, wr, wc, fr, fq);
        if (!has_next) break;
#pragma unroll
        for (int a = 0; a < 2; ++a)
#pragma unroll
            for (int b = 0; b < 2; ++b)
#pragma unroll
                for (int m = 0; m < 4; ++m)
#pragma unroll
                    for (int n = 0; n < 2; ++n) acc[a][b][m][n] = (f32x4){0.f, 0.f, 0.f, 0.f};
        cur = nxt; cA0 = nA0; cA1 = nA1; cB = nB; ++ui;
        if (wr == 1) PG8_BAR;
    }
    PG8_WAIT_V(0);
    PG8_BAR;
#undef PG8_SA
#undef PG8_GETOFF
#undef PG8_SB
#undef PG8_STAGE
#undef PG8_LDA
#undef PG8_LDB
#undef PG8_MMA
#undef PG8_WAIT_V
#undef PG8_WAIT_L
#undef PG8_BAR
#undef PG8_SCHED
}

struct Params {
    const float* x; const int* pos; const float* w_in; const float* lb_logits; const float* hg_norm_g; const float* ret_norm_g;
    const float* w_bh; const float* w_br; const float* w_out; const float* ln1_g; const float* ln1_b;
    const float* w_group; const float* b_group; const float* w_router; const float* b_router;
    const float* w1; const float* w3; const float* w2; const float* ln2_g; const float* ln2_b;
    float* out; unsigned char* ws;
};

enum { ACT_NONE = 0, ACT_SILU = 1, ACT_LOGF = 2, ACT_ROTQ = 3, ACT_ROTK = 4, ACT_SIG = 5 };
struct StaticSchedBase {
    static constexpr bool GATHER = false;
    __device__ __forceinline__ int row_id(const Unit&, int) const { return 0; }
};
constexpr int NHR = 896;
constexpr int NGA_H = NHR - (512 - 4 * RG2_PANELS);
struct SchedProj : StaticSchedBase {
    TileOrder to; const char* A; const char* Bt; int col0; unsigned kinds; int G, c;
    __device__ __forceinline__ bool next(int i, Unit& u) const {
        int pm, pn; if (!to.get((long)i * G + c, pm, pn)) return false;
        u.pm = pm; u.pn = pn; u.A = A + (size_t)pm * 256 * 2048; u.B = Bt + (size_t)(col0 + pn * 256) * 2048;
        u.aux = pn >> 2; u.kind = (int)((kinds >> (4 * (pn >> 2))) & 15u); return true;
    }
};
struct SchedMix : StaticSchedBase {
    TileOrder to; const char* xb; const char* ohg; const char* oret; const char* win; const char* wbh; const char* wbr; int G, c;
    __device__ __forceinline__ bool next(int i, Unit& u) const {
        int pm, pn, k, j = i; long L = c;
        for (;;) { if (L >= 512) return false; if (j < 2) { k = 1 + 2 * j; break; } j -= 2; L += G; }
        to.get(L, pm, pn);
        u.pm = pm; u.pn = pn; u.kind = k; u.aux = 0;
        const size_t ao = (size_t)pm * 256 * 2048, bo = (size_t)pn * 256 * 2048;
        if (k == 0)      { u.A = xb + ao;   u.B = win + (size_t)9216 * 2048 + bo; }
        else if (k == 1) { u.A = xb + ao;   u.B = win + (size_t)10240 * 2048 + bo; }
        else if (k == 2) { u.A = ohg + ao;  u.B = wbh + bo; }
        else             { u.A = oret + ao; u.B = wbr + bo; }
        return true;
    }
};
struct SchedGates2 : StaticSchedBase {
    TileOrder to; const char* A; const char* Bt; int G, c, xq, xj;
    __device__ __forceinline__ bool next(int i, Unit& u) const {
        int pm, pn; bool isg;
        if (xq >= 0) { if (i >= 8) return false; isg = i >= 4; pm = 32 * (i & 3) + 8 * xq + (xj & 7); pn = xj >> 3; }
        else { const long L = (long)i * G + c; if (L >= 1024) return false; isg = L >= 512; to.get(isg ? L - 512 : L, pm, pn); }
        u.B = Bt + (size_t)((isg ? 9216 : 4096) + pn * 256) * 2048; u.aux = isg ? 7 : 4;
        u.pm = pm; u.pn = pn; u.A = A + (size_t)pm * 256 * 2048; u.kind = isg ? ACT_SIG : ACT_SILU; return true;
    }
};
struct SchedProjR : StaticSchedBase {
    TileOrder to; const char* A; const char* Bt; int G, c;
    __device__ __forceinline__ bool next(int i, Unit& u) const {
        const long L = (long)i * G + c; if (L >= 1536) return false;
        int pm, pn; to.get(L, pm, pn); u.pm = pm; u.pn = pn; u.A = A + (size_t)pm * 256 * 2048; u.B = Bt + (size_t)(5120 + pn * 256) * 2048;
        u.aux = pn >> 2; u.kind = (pn >> 2) == 0 ? ACT_ROTQ : ((pn >> 2) == 1 ? ACT_ROTK : ACT_NONE); return true;
    }
};
struct SchedRetHelp : StaticSchedBase {
    TileOrder to; const char* A; const char* Bt; const char* ohg; const char* wbh; int G, c, xq, xj;
    __device__ __forceinline__ bool next(int i, Unit& u) const {
        bool isp; int pm, pn;
        if (xq >= 0) { if (i >= 8) return false; isp = i >= 4; pm = 32 * (i & 3) + 8 * xq + (xj & 7); pn = xj >> 3; }
        else { const long L = (long)i * G + c; if (L >= 1024) return false; isp = L >= 512; to.get(isp ? L - 512 : L, pm, pn); }
        u.pm = pm; u.pn = pn;
        if (isp) { u.A = ohg + (size_t)pm * 256 * 2048; u.B = wbh + (size_t)pn * 256 * 2048; u.aux = 8; u.kind = 2; }
        else { u.A = A + (size_t)pm * 256 * 2048; u.B = Bt + (size_t)(8192 + pn * 256) * 2048; u.aux = 5; u.kind = ACT_SILU; }
        return true;
    }
};
struct SchedPlain : StaticSchedBase {
    TileOrder to; const char* A; const char* Bt; int G, c; int K;
    __device__ __forceinline__ bool next(int i, Unit& u) const {
        int pm, pn; if (!to.get((long)i * G + c, pm, pn)) return false;
        u.pm = pm; u.pn = pn; u.kind = 0; u.aux = 0; u.A = A + (size_t)pm * 256 * K * 2; u.B = Bt + (size_t)pn * 256 * K * 2; return true;
    }
};
struct SchedMoe {
    const LAS int* tab; int G, c; int NU, per;
    const char* Abase; const char* Bbase; size_t b_estride; int K; bool gather;
    const int* lent;
    __device__ __forceinline__ void init_counts() { NU = tab[64] * 4; per = (NU + 7) / 8; }
    __device__ __forceinline__ bool decode(int i, int& e, int& mt, int& nt) const {
        const long L = (long)i * G + c; const int x = (int)(L % 8); const long j = L / 8;
        if (j >= per) return false; const long idx = (long)x * per + j; if (idx >= NU) return false;
        int ee = 0;
#pragma unroll 1
        for (int q = 1; q < 32; ++q) { if (4 * tab[32 + q] <= idx) ee = q; }
        e = ee; const int tiles = (tab[e] + 255) >> 8; const int r = (int)(idx - 4 * tab[32 + e]);
        nt = r / tiles; mt = r % tiles; return true;
    }
};
struct SchedMoe1 : SchedMoe {
    static constexpr bool GATHER = true;
    __device__ __forceinline__ bool next(int i, Unit& u) const {
        int e, mt, nt; if (!decode(i, e, mt, nt)) return false;
        u.pm = tab[32 + e] + mt; u.pn = nt; u.aux = e; u.kind = mt; u.A = Abase; u.B = Bbase + (size_t)e * b_estride + (size_t)nt * 256 * K * 2; return true;
    }
    __device__ __forceinline__ int row_id(const Unit& u, int r) const {
        const int cnt = tab[u.aux]; const int pp = u.kind * 256 + r;
        return (pp < cnt) ? (lent[(size_t)u.aux * LCAP + pp] >> 1) : 0;
    }
};
struct SchedMoe2 : SchedMoe {
    static constexpr bool GATHER = false;
    __device__ __forceinline__ bool next(int i, Unit& u) const {
        int e, mt, nt; if (!decode(i, e, mt, nt)) return false;
        u.pm = tab[32 + e] + mt; u.pn = nt; u.aux = e; u.kind = mt; u.A = Abase + (size_t)u.pm * 256 * K * 2; u.B = Bbase + (size_t)e * b_estride + (size_t)nt * 256 * K * 2; return true;
    }
    __device__ __forceinline__ int row_id(const Unit&, int) const { return 0; }
};

#define EPI_ROWLOOP for (int ai = 0; ai < 2; ++ai) for (int m = 0; m < 4; ++m)
struct EpiProj {
    bf16_t* U0; bf16_t* dgate; const float* lb; const int* pos; const double* inv2pi; bf16_t* dgate2; bf16_t* dgate3; bf16_t* dgate4;
    __device__ __forceinline__ void operator()(const f32x4 (&acc)[2][2][4][2], const Unit& u, int wr, int wc, int fr, int fq) const {
        bf16_t* dst = (u.aux < 4) ? U0 + (size_t)u.aux * (USTR / 2) : (u.aux == 4 ? dgate : (u.aux == 5 ? dgate2 : (u.aux == 6 ? dgate3 : dgate4)));
        const int kind = u.kind;
        const int cg0 = (u.pn & 3) * 256 + wc * 32 + 8 * fq;
        const int row0 = u.pm * 256 + wr * 64 + fr;
        if (kind == ACT_ROTQ || kind == ACT_ROTK) {
            const float sc = (kind == ACT_ROTK) ? 0.0625f : 1.0f;
            float ivh[2][4], ivl[2][4];
#pragma unroll
            for (int bj = 0; bj < 2; ++bj)
#pragma unroll
                for (int j = 0; j < 4; ++j) { const int pi = (bj * 128 + wc * 32 + 8 * fq) / 2 + j; ivh[bj][j] = ((const float*)inv2pi)[2 * pi]; ivl[bj][j] = ((const float*)inv2pi)[2 * pi + 1]; }
            int posv[2][4];
#pragma unroll
            for (int ai = 0; ai < 2; ++ai)
#pragma unroll
                for (int m = 0; m < 4; ++m) posv[ai][m] = pos[row0 + ai * 128 + m * 16];
#pragma unroll
            for (int ai = 0; ai < 2; ++ai)
#pragma unroll
                for (int m = 0; m < 4; ++m) {
                    const int row = row0 + ai * 128 + m * 16; const float pf = (float)posv[ai][m];
#pragma unroll
                    for (int bj = 0; bj < 2; ++bj) {
                        const f32x4 v0 = acc[ai][bj][m][0], v1 = acc[ai][bj][m][1];
                        float o[8]; const float in[8] = {v0[0], v0[1], v0[2], v0[3], v1[0], v1[1], v1[2], v1[3]};
#pragma unroll
                        for (int j = 0; j < 4; ++j) {
                            const float r = __builtin_amdgcn_fractf(__builtin_amdgcn_fractf(pf * ivh[bj][j]) + __builtin_amdgcn_fractf(pf * ivl[bj][j]));
                            const float sn = __builtin_amdgcn_sinf(r), cs = __builtin_amdgcn_cosf(r);
                            const float t1 = in[2 * j], t2 = in[2 * j + 1];
                            o[2 * j] = (t1 * cs - t2 * sn) * sc; o[2 * j + 1] = (t1 * sn + t2 * cs) * sc;
                        }
                        u32x4 w; w.x = pk2(o[0], o[1]); w.y = pk2(o[2], o[3]); w.z = pk2(o[4], o[5]); w.w = pk2(o[6], o[7]);
                        {
                            const int t = row & 63, d0 = bj * 128 + wc * 32 + 8 * fq; const int f = 8 * (t >> 4) + (d0 >> 5), L = (t & 15) + 16 * ((d0 >> 3) & 3);
                            *(u32x4*)(dst + (size_t)(row - t + 2 * f + (L >> 5)) * DM + (u.pn & 3) * 256 + (L & 31) * 8) = w; }
                    }
                }
            return;
        }
        f32x4 lb0[2], lb1[2];
#pragma unroll
        for (int bj = 0; bj < 2; ++bj) { lb0[bj] = (f32x4){0.f, 0.f, 0.f, 0.f}; lb1[bj] = lb0[bj]; }
        if (kind == ACT_LOGF) {
#pragma unroll
            for (int bj = 0; bj < 2; ++bj) { lb0[bj] = *(const f32x4*)(lb + cg0 + bj * 128); lb1[bj] = *(const f32x4*)(lb + cg0 + bj * 128 + 4); }
        }
#pragma unroll
        for (int ai = 0; ai < 2; ++ai)
#pragma unroll
            for (int m = 0; m < 4; ++m) {
                const int row = row0 + ai * 128 + m * 16;
#pragma unroll
                for (int bj = 0; bj < 2; ++bj) {
                    f32x4 v0 = acc[ai][bj][m][0], v1 = acc[ai][bj][m][1];
                    if (kind == ACT_SILU) {
#pragma unroll
                        for (int j = 0; j < 4; ++j) { v0[j] = siluf_(v0[j]); v1[j] = siluf_(v1[j]); }
                    } else if (kind == ACT_SIG) {
#pragma unroll
                        for (int j = 0; j < 4; ++j) { v0[j] = sigmoidf_(v0[j]); v1[j] = sigmoidf_(v1[j]); }
                    } else if (kind == ACT_LOGF) {
#pragma unroll
                        for (int j = 0; j < 4; ++j) { v0[j] = __log2f(lb0[bj][j] + (1.f - lb0[bj][j]) * sigmoidf_(v0[j])); v1[j] = __log2f(lb1[bj][j] + (1.f - lb1[bj][j]) * sigmoidf_(v1[j])); }
                    }
                    u32x4 w; w.x = pk2(v0[0], v0[1]); w.y = pk2(v0[2], v0[3]); w.z = pk2(v1[0], v1[1]); w.w = pk2(v1[2], v1[3]);
                    *(u32x4*)(dst + (size_t)row * DM + cg0 + bj * 128) = w;
                }
            }
    }
};
struct EpiMix {
    bf16_t* ga; bf16_t* gb; bf16_t* part; bf16_t* merged;
    __device__ __forceinline__ void operator()(const f32x4 (&acc)[2][2][4][2], const Unit& u, int wr, int wc, int fr, int fq) const {
        const int kind = u.kind;
        const int c0 = u.pn * 256 + wc * 32 + 8 * fq; const int row0 = u.pm * 256 + wr * 64 + fr;
        if (kind < 2) {
            bf16_t* dst = (kind == 0) ? ga : gb;
#pragma unroll
            for (int ai = 0; ai < 2; ++ai)
#pragma unroll
                for (int m = 0; m < 4; ++m)
#pragma unroll
                    for (int bj = 0; bj < 2; ++bj) {
                        f32x4 v0 = acc[ai][bj][m][0], v1 = acc[ai][bj][m][1];
#pragma unroll
                        for (int j = 0; j < 4; ++j) { v0[j] = sigmoidf_(v0[j]); v1[j] = sigmoidf_(v1[j]); }
                        u32x4 w; w.x = pk2(v0[0], v0[1]); w.y = pk2(v0[2], v0[3]); w.z = pk2(v1[0], v1[1]); w.w = pk2(v1[2], v1[3]);
                        *(u32x4*)(dst + (size_t)(row0 + ai * 128 + m * 16) * DM + c0 + bj * 128) = w;
                    }
            return;
        }
        const bf16_t* gp = (kind == 2) ? ga : gb;
#pragma unroll
        for (int ai = 0; ai < 2; ++ai) {
            u32x4 g[4][2], pw[4][2];
#pragma unroll
            for (int m = 0; m < 4; ++m)
#pragma unroll
                for (int bj = 0; bj < 2; ++bj) { const size_t o = (size_t)(row0 + ai * 128 + m * 16) * DM + c0 + bj * 128;
                    g[m][bj] = *(const u32x4*)(gp + o); pw[m][bj] = (kind == 3) ? *(const u32x4*)(part + o) : (u32x4){0u, 0u, 0u, 0u}; }
#pragma unroll
            for (int m = 0; m < 4; ++m)
#pragma unroll
                for (int bj = 0; bj < 2; ++bj) { const size_t o = (size_t)(row0 + ai * 128 + m * 16) * DM + c0 + bj * 128;
                    f32x4 v0 = acc[ai][bj][m][0], v1 = acc[ai][bj][m][1]; const u32x4 gg = g[m][bj], pp = pw[m][bj];
                    v0[0] = v0[0] * bflo(gg.x) + bflo(pp.x); v0[1] = v0[1] * bfhi(gg.x) + bfhi(pp.x); v0[2] = v0[2] * bflo(gg.y) + bflo(pp.y); v0[3] = v0[3] * bfhi(gg.y) + bfhi(pp.y);
                    v1[0] = v1[0] * bflo(gg.z) + bflo(pp.z); v1[1] = v1[1] * bfhi(gg.z) + bfhi(pp.z); v1[2] = v1[2] * bflo(gg.w) + bflo(pp.w); v1[3] = v1[3] * bfhi(gg.w) + bfhi(pp.w);
                    u32x4 w; w.x = pk2(v0[0], v0[1]); w.y = pk2(v0[2], v0[3]); w.z = pk2(v1[0], v1[1]); w.w = pk2(v1[2], v1[3]);
                    *(u32x4*)(((kind == 2) ? part : merged) + o) = w; }
        }
    }
};
struct EpiRetHelp {
    EpiProj P; EpiMix M;
    __device__ __forceinline__ void operator()(const f32x4 (&acc)[2][2][4][2], const Unit& u, int wr, int wc, int fr, int fq) const {
        if (u.aux == 8) M(acc, u, wr, wc, fr, fq); else P(acc, u, wr, wc, fr, fq);
    }
};
struct EpiPre1 {
    const float* x; float* out;
    __device__ __forceinline__ void operator()(const f32x4 (&acc)[2][2][4][2], const Unit& u, int wr, int wc, int fr, int fq) const {
        const int c0 = u.pn * 256 + wc * 32 + 8 * fq; const int row0 = u.pm * 256 + wr * 64 + fr;
#pragma unroll
        for (int ai = 0; ai < 2; ++ai)
#pragma unroll
            for (int mh = 0; mh < 2; ++mh) {
                f32x4 xv[2][2][2];
#pragma unroll
                for (int m2 = 0; m2 < 2; ++m2)
#pragma unroll
                    for (int bj = 0; bj < 2; ++bj) { const size_t o = (size_t)(row0 + ai * 128 + (2 * mh + m2) * 16) * DM + c0 + bj * 128;
                        xv[m2][bj][0] = *(const f32x4*)(x + o); xv[m2][bj][1] = *(const f32x4*)(x + o + 4); }
#pragma unroll
                for (int m2 = 0; m2 < 2; ++m2)
#pragma unroll
                    for (int bj = 0; bj < 2; ++bj) { const size_t o = (size_t)(row0 + ai * 128 + (2 * mh + m2) * 16) * DM + c0 + bj * 128;
                        *(f32x4*)(out + o) = xv[m2][bj][0] * ALPHA + acc[ai][bj][2 * mh + m2][0]; *(f32x4*)(out + o + 4) = xv[m2][bj][1] * ALPHA + acc[ai][bj][2 * mh + m2][1]; }
            }
    }
};
struct EpiMoe1 {
    bf16_t* H;
    __device__ __forceinline__ void operator()(const f32x4 (&acc)[2][2][4][2], const Unit& u, int wr, int wc, int fr, int fq) const {
        const int hc0 = (u.pn * 256 + wc * 32 + 8 * fq) >> 1; const int row0 = u.pm * 256 + wr * 64 + fr;
#pragma unroll
        for (int ai = 0; ai < 2; ++ai)
#pragma unroll
            for (int m = 0; m < 4; ++m) {
                const size_t ro = (size_t)(row0 + ai * 128 + m * 16) * 512 + hc0;
#pragma unroll
                for (int bj = 0; bj < 2; ++bj) {
                    const f32x4 v0 = acc[ai][bj][m][0], v1 = acc[ai][bj][m][1];
                    u32x2 w; w.x = pk2(siluf_(v0[0]) * v0[1], siluf_(v0[2]) * v0[3]); w.y = pk2(siluf_(v1[0]) * v1[1], siluf_(v1[2]) * v1[3]);
                    *(u32x2*)(H + ro + bj * 64) = w;
                }
            }
    }
};
struct EpiMoe2 {
    bf16_t* Y0; long ydelta; const int* lent; const float* lw; const LAS int* tab;
    __device__ __forceinline__ void operator()(const f32x4 (&acc)[2][2][4][2], const Unit& u, int wr, int wc, int fr, int fq) const {
        const int c0 = u.pn * 256 + wc * 32 + 8 * fq; const int e = u.aux, cnt = tab[e];
        const int* le = lent + (size_t)e * LCAP; const float* lwp = lw + (size_t)e * LCAP;
        int ents[2][4]; float wts[2][4];
#pragma unroll
        for (int ai = 0; ai < 2; ++ai)
#pragma unroll
            for (int m = 0; m < 4; ++m) { const int p = u.kind * 256 + ai * 128 + wr * 64 + m * 16 + fr; const bool ok = p < cnt; ents[ai][m] = ok ? le[p] : 0; wts[ai][m] = ok ? lwp[p] : 0.f; }
#pragma unroll
        for (int ai = 0; ai < 2; ++ai)
#pragma unroll
            for (int m = 0; m < 4; ++m) {
                const int p = u.kind * 256 + ai * 128 + wr * 64 + m * 16 + fr;
                if (p < cnt) {
                    const int ent = ents[ai][m]; const float w = wts[ai][m];
                    bf16_t* yb = Y0 + (long)(ent & 1) * ydelta + (size_t)(ent >> 1) * DM + c0;
#pragma unroll
                    for (int bj = 0; bj < 2; ++bj) {
                        const f32x4 v0 = acc[ai][bj][m][0] * w, v1 = acc[ai][bj][m][1] * w;
                        u32x4 o; o.x = pk2(v0[0], v0[1]); o.y = pk2(v0[2], v0[3]); o.z = pk2(v1[0], v1[1]); o.w = pk2(v1[2], v1[3]);
                        *(u32x4*)(yb + bj * 128) = o;
                    }
                }
            }
    }
};

__device__ __forceinline__ void transpose_item(const float* W, int K, int N, bf16_t* WT, int row_off, int rmul, int radd, LAS float* scr, int item, int lane) {
    const int nblk = N / 32, kb = item / nblk, nb = item % nblk, k0 = 64 * kb, n0 = 32 * nb;
#pragma unroll 8
    for (int i = 0; i < 32; ++i) { const int kk = 2 * i + (lane >> 5); scr[kk * 33 + (lane & 31)] = W[(size_t)(k0 + kk) * N + n0 + (lane & 31)]; }
    asm volatile("s_waitcnt lgkmcnt(0)" ::: "memory");
    const int c = lane & 7;
#pragma unroll
    for (int j = 0; j < 4; ++j) { const int n = (lane >> 3) + 8 * j; const LAS float* s = scr + (8 * c) * 33 + n;
        u32x4 o; o.x = pk2(s[0 * 33], s[1 * 33]); o.y = pk2(s[2 * 33], s[3 * 33]); o.z = pk2(s[4 * 33], s[5 * 33]); o.w = pk2(s[6 * 33], s[7 * 33]);
        *(u32x4*)(WT + (size_t)(row_off + (n0 + n) * rmul + radd) * K + k0 + 8 * c) = o; }
    asm volatile("s_waitcnt lgkmcnt(0)" ::: "memory");
}
__device__ __forceinline__ void p0_prep(const Params& p, LAS unsigned char* lds) {
    int tid = threadIdx.x; asm volatile("" : "+v"(tid));
    const int lane = tid & 63, wave = tid >> 6;
    const int gw = blockIdx.x * 8 + wave, NGW = gridDim.x * 8;
    LAS float* scr = (LAS float*)(lds + wave * 16384);
    bf16_t* WIN = (bf16_t*)(p.ws + OFF_WIN);
    constexpr int I_IN = 16 * (11264 / 32), I_SQ = 16 * 32;
    for (int it = gw; it < I_IN + 3 * I_SQ; it += NGW) {
        int r = it;
        if (r < I_IN) { transpose_item(p.w_in, 1024, 11264, WIN, 0, 1, 0, scr, r, lane); continue; } r -= I_IN;
        if (r < I_SQ) { transpose_item(p.w_bh, 1024, 1024, (bf16_t*)(p.ws + OFF_WBH), 0, 1, 0, scr, r, lane); continue; } r -= I_SQ;
        if (r < I_SQ) { transpose_item(p.w_br, 1024, 1024, (bf16_t*)(p.ws + OFF_WBR), 0, 1, 0, scr, r, lane); continue; } r -= I_SQ;
        transpose_item(p.w_out, 1024, 1024, (bf16_t*)(p.ws + OFF_WO), 0, 1, 0, scr, r, lane);
    }
    const size_t gt = (size_t)blockIdx.x * 512 + tid, gs = (size_t)gridDim.x * 512;
    u32x4* xb = (u32x4*)(p.ws + OFF_XB); const f32x4* x4 = (const f32x4*)p.x;
    for (size_t i = gt; i < TD / 8; i += gs) { const f32x4 a = x4[2 * i], b = x4[2 * i + 1]; u32x4 o; o.x = pk2(a[0], a[1]); o.y = pk2(a[2], a[3]); o.z = pk2(b[0], b[1]); o.w = pk2(b[2], b[3]); xb[i] = o; }
    float* lb = (float*)(p.ws + OFF_LB); double* inv = (double*)(p.ws + OFF_INV); float* wrt = (float*)(p.ws + OFF_WRT);
    for (size_t i = gt; i < 1024; i += gs) lb[i] = 1.0f / (1.0f + expf(p.lb_logits[i] - p.lb_logits[1024 + i]));
    for (size_t i = gt; i < 128; i += gs) { const double v = exp(-9.210340371976184 * (double)i / 127.0) * 0.15915494309189535;
        const float hi = __uint_as_float(__float_as_uint((float)v) & 0xffffc000u);
        ((float*)inv)[2 * i] = hi; ((float*)inv)[2 * i + 1] = (float)(v - (double)hi); }
    for (size_t i = gt; i < 36 * 1024; i += gs) { const int j = (int)(i >> 10), k = (int)(i & 1023); wrt[i] = (j < 4) ? p.w_group[k * 4 + j] : p.w_router[k * 32 + (j - 4)]; }
}

constexpr int QK_STR = 272, VT_STR = 144;
constexpr int L_QF = 0, L_KF = 17408, L_QB = 34816, L_KB = 52224, L_VT = 69632, L_A = 88064, L_SEGF = 97280, L_SEGB = 101376;
__device__ __forceinline__ float clamp80(float x) { return fminf(fmaxf(x, -115.f), 115.f); }
__device__ __forceinline__ void hgrn_p2a(bf16_t* Uq, bf16_t* Ulf, bf16_t* Ulb, bf16_t* Uv, bf16_t* Uqb, bf16_t* Uo, float* af, float* ab, LAS unsigned char* lds) {
    int tid = threadIdx.x; asm volatile("" : "+v"(tid));
    const int lane = tid & 63, seg = __builtin_amdgcn_readfirstlane(tid >> 6), dp = lane, l15 = lane & 15, kg = lane >> 4;
    LAS float* SEGF = (LAS float*)(lds + L_SEGF); LAS float* SEGB = (LAS float*)(lds + L_SEGB);
    unsigned wq[8], wv[8], wf[8], wb[8];
#define HA_LOAD(tk) do { const int h_ = (tk) & 7, n_ = ((tk) >> 3) & 127, b_ = (tk) >> 10; const size_t R0_ = (size_t)b_ * SEQ + 64 * n_; \
        _Pragma("unroll") for (int i = 0; i < 8; ++i) { const size_t g = (R0_ + 8 * seg + i) * DM + h_ * 128 + 2 * dp; \
            wq[i] = *(const unsigned*)(Uq + g); wf[i] = *(const unsigned*)(Ulf + g); wb[i] = *(const unsigned*)(Ulb + g); wv[i] = *(const unsigned*)(Uv + g); } } while (0)
    if ((int)blockIdx.x < 4 * 128 * 8) HA_LOAD((int)blockIdx.x);
    for (int task = blockIdx.x; task < 4 * 128 * 8; task += gridDim.x) {
        const int h = task & 7, n = (task >> 3) & 127, b = task >> 10;
        const size_t R0 = (size_t)b * SEQ + 64 * n;
        float pf0[8], pf1[8], sb0[8], sb1[8];
        { float r0 = 0.f, r1 = 0.f;
#pragma unroll
          for (int i = 0; i < 8; ++i) { r0 += bflo(wf[i]); r1 += bfhi(wf[i]); pf0[i] = r0; pf1[i] = r1; }
          r0 = 0.f; r1 = 0.f;
#pragma unroll
          for (int i = 7; i >= 0; --i) { r0 += bflo(wb[i]); r1 += bfhi(wb[i]); sb0[i] = r0; sb1[i] = r1; } }
        SEGF[seg * 128 + 2 * dp] = pf0[7]; SEGF[seg * 128 + 2 * dp + 1] = pf1[7]; SEGB[seg * 128 + 2 * dp] = sb0[0]; SEGB[seg * 128 + 2 * dp + 1] = sb1[0];
        asm volatile("s_waitcnt vmcnt(0)" ::: "memory");
        __syncthreads();
        float offf0 = 0.f, offf1 = 0.f, mf0 = 0.f, mf1 = 0.f, totf0 = 0.f, totf1 = 0.f, offb0 = 0.f, offb1 = 0.f, mb0 = 0.f, mb1 = 0.f, totb0 = 0.f, totb1 = 0.f;
#pragma unroll
        for (int s2 = 0; s2 < 8; ++s2) {
            const float x0 = SEGF[s2 * 128 + 2 * dp], x1 = SEGF[s2 * 128 + 2 * dp + 1], y0 = SEGB[s2 * 128 + 2 * dp], y1 = SEGB[s2 * 128 + 2 * dp + 1];
            if (s2 < seg) { offf0 += x0; offf1 += x1; } if (s2 < 4) { mf0 += x0; mf1 += x1; } totf0 += x0; totf1 += x1;
            if (s2 > seg) { offb0 += y0; offb1 += y1; } if (s2 >= 4) { mb0 += y0; mb1 += y1; } totb0 += y0; totb1 += y1;
        }
        const float emf0 = __builtin_amdgcn_exp2f(mf0), emf1 = __builtin_amdgcn_exp2f(mf1), emb0 = __builtin_amdgcn_exp2f(mb0), emb1 = __builtin_amdgcn_exp2f(mb1);
        const float etf0 = __builtin_amdgcn_exp2f(totf0 - mf0), etf1 = __builtin_amdgcn_exp2f(totf1 - mf1), etb0 = __builtin_amdgcn_exp2f(totb0 - mb0), etb1 = __builtin_amdgcn_exp2f(totb1 - mb1);
        unsigned kdf0[4], kdf1[4], kdb0[4], kdb1[4], vt0[4], vt1[4];
        float pk_a[6][2];
#pragma unroll
        for (int i = 0; i < 8; ++i) {
            const int t = 8 * seg + i; const size_t g = (R0 + t) * DM + h * 128 + 2 * dp;
            const float q0 = bflo(wq[i]), q1 = bfhi(wq[i]), v0 = bflo(wv[i]), v1 = bfhi(wv[i]);
#define EX2(x) __builtin_amdgcn_exp2f(x)
            const float kf0 = 1.f - EX2(bflo(wf[i])), kf1 = 1.f - EX2(bfhi(wf[i])), kb0 = 1.f - EX2(bflo(wb[i])), kb1 = 1.f - EX2(bfhi(wb[i]));
            const float Gf0 = offf0 + pf0[i], Gf1 = offf1 + pf1[i], Gb0 = offb0 + sb0[i], Gb1 = offb1 + sb1[i];
            const float ef0 = EX2(clamp80(Gf0 - mf0)), ef1 = EX2(clamp80(Gf1 - mf1)), eb0 = EX2(clamp80(Gb0 - mb0)), eb1 = EX2(clamp80(Gb1 - mb1));
            const float qtf0 = q0 * ef0, qtf1 = q1 * ef1, qtb0 = q0 * eb0, qtb1 = q1 * eb1;
            const float ktf0 = kf0 * __builtin_amdgcn_rcpf(ef0), ktf1 = kf1 * __builtin_amdgcn_rcpf(ef1), ktb0 = kb0 * __builtin_amdgcn_rcpf(eb0), ktb1 = kb1 * __builtin_amdgcn_rcpf(eb1);
            {
                const size_t gq = (R0 + 4 * (4 * (t >> 4) + (dp >> 4)) + ((dp >> 2) & 3)) * DM + h * 128 + (t & 15) * 8 + 2 * (dp & 3);
                *(unsigned*)(Uq + gq) = pk2(qtf0 * emf0, qtf1 * emf1);
                *(unsigned*)(Uqb + gq) = pk2(qtb0 * emb0, qtb1 * emb1); }
            *(LAS unsigned*)(lds + L_QF + t * QK_STR + 4 * dp) = pk2(qtf0, qtf1);
            *(LAS unsigned*)(lds + L_KF + t * QK_STR + 4 * dp) = pk2(ktf0, ktf1);
            *(LAS unsigned*)(lds + L_QB + t * QK_STR + 4 * dp) = pk2(qtb0, qtb1);
            *(LAS unsigned*)(lds + L_KB + t * QK_STR + 4 * dp) = pk2(ktb0, ktb1);
            const float a0 = ktf0 * etf0, a1 = ktf1 * etf1, c0 = ktb0 * etb0, c1 = ktb1 * etb1;
            if ((i & 1) == 0) { pk_a[0][0] = a0; pk_a[1][0] = a1; pk_a[2][0] = c0; pk_a[3][0] = c1; pk_a[4][0] = v0; pk_a[5][0] = v1; }
            else { kdf0[i >> 1] = pk2(pk_a[0][0], a0); kdf1[i >> 1] = pk2(pk_a[1][0], a1); kdb0[i >> 1] = pk2(pk_a[2][0], c0); kdb1[i >> 1] = pk2(pk_a[3][0], c1);
                   vt0[i >> 1] = pk2(pk_a[4][0], v0); vt1[i >> 1] = pk2(pk_a[5][0], v1); }
        }
        {
            const int d0 = 2 * dp, d1 = d0 + 1;
            const size_t g = (R0 + 4 * (4 * (d0 >> 5) + 2 * ((d0 >> 4) & 1) + (seg >> 2)) + (seg & 3)) * DM + h * 128 + (d0 & 15) * 8;
            const size_t g1 = g + 8;
            (void)d1;
            *(u32x4*)(Ulf + g) = (u32x4){kdf0[0], kdf0[1], kdf0[2], kdf0[3]}; *(u32x4*)(Ulf + g1) = (u32x4){kdf1[0], kdf1[1], kdf1[2], kdf1[3]};
            *(u32x4*)(Ulb + g) = (u32x4){kdb0[0], kdb0[1], kdb0[2], kdb0[3]}; *(u32x4*)(Ulb + g1) = (u32x4){kdb1[0], kdb1[1], kdb1[2], kdb1[3]};
            *(LAS u32x4*)(lds + L_VT + (2 * dp) * VT_STR + 16 * seg) = (u32x4){vt0[0], vt0[1], vt0[2], vt0[3]};
            *(LAS u32x4*)(lds + L_VT + (2 * dp + 1) * VT_STR + 16 * seg) = (u32x4){vt1[0], vt1[1], vt1[2], vt1[3]};
            if (seg == 0) { const size_t ao = ((size_t)(b * 128 + n)) * DM + h * 128 + 2 * dp; af[ao] = __builtin_amdgcn_exp2f(totf0); af[ao + 1] = __builtin_amdgcn_exp2f(totf1); ab[ao] = __builtin_amdgcn_exp2f(totb0); ab[ao + 1] = __builtin_amdgcn_exp2f(totb1); }
        }
        if (task + (int)gridDim.x < 4 * 128 * 8) HA_LOAD(task + (int)gridDim.x);
        __syncthreads();
        {
            const int ti = seg & 3, sp = seg >> 2;
            f32x4 accf[2], accb[2];
#pragma unroll
            for (int u = 0; u < 2; ++u) { accf[u] = (f32x4){0.f, 0.f, 0.f, 0.f}; accb[u] = accf[u]; }
#pragma unroll
            for (int ks = 0; ks < 4; ++ks) {
                const int ko = (ks * 32 + 8 * kg) * 2;
                const bf16x8 qf_ = *(const LAS bf16x8*)(lds + L_QF + (16 * ti + l15) * QK_STR + ko), qb_ = *(const LAS bf16x8*)(lds + L_QB + (16 * ti + l15) * QK_STR + ko);
#pragma unroll
                for (int u = 0; u < 2; ++u) { const int si = 2 * sp + u;
                    const bf16x8 kf_ = *(const LAS bf16x8*)(lds + L_KF + (16 * si + l15) * QK_STR + ko), kb_ = *(const LAS bf16x8*)(lds + L_KB + (16 * si + l15) * QK_STR + ko);
                    accf[u] = __builtin_amdgcn_mfma_f32_16x16x32_bf16(kf_, qf_, accf[u], 0, 0, 0);
                    accb[u] = __builtin_amdgcn_mfma_f32_16x16x32_bf16(kb_, qb_, accb[u], 0, 0, 0); }
            }
#pragma unroll
            for (int u = 0; u < 2; ++u) { const int si = 2 * sp + u; const int t = 16 * ti + l15; float o4[4];
#pragma unroll
                for (int j = 0; j < 4; ++j) { const int sidx = 16 * si + 4 * kg + j; o4[j] = (sidx <= t ? accf[u][j] : 0.f) + (sidx >= t ? accb[u][j] : 0.f); }
                *(LAS u32x2*)(lds + L_A + t * VT_STR + (16 * si + 4 * kg) * 2) = (u32x2){pk2(o4[0], o4[1]), pk2(o4[2], o4[3])}; }
        }
        __syncthreads();
        {
            f32x4 acco[4];
#pragma unroll
            for (int ti = 0; ti < 4; ++ti) acco[ti] = (f32x4){0.f, 0.f, 0.f, 0.f};
#pragma unroll
            for (int k2 = 0; k2 < 2; ++k2) { const int ko = (k2 * 32 + 8 * kg) * 2;
                const bf16x8 vt_ = *(const LAS bf16x8*)(lds + L_VT + (16 * seg + l15) * VT_STR + ko);
#pragma unroll
                for (int ti = 0; ti < 4; ++ti) { const bf16x8 a_ = *(const LAS bf16x8*)(lds + L_A + (16 * ti + l15) * VT_STR + ko);
                    acco[ti] = __builtin_amdgcn_mfma_f32_16x16x32_bf16(vt_, a_, acco[ti], 0, 0, 0); } }
#pragma unroll
            for (int ti = 0; ti < 4; ++ti) *(u32x2*)(Uo + (R0 + 16 * ti + l15) * DM + h * 128 + 16 * seg + 4 * kg) = (u32x2){pk2(acco[ti][0], acco[ti][1]), pk2(acco[ti][2], acco[ti][3])};
        }
    }
}

template <int PITCH> __device__ __forceinline__ bf16x8 ld_T(const LAS unsigned char* p) {
    unsigned w[4];
#pragma unroll
    for (int q = 0; q < 4; ++q) w[q] = (unsigned)*(const LAS unsigned short*)(p + (2 * q) * PITCH) | ((unsigned)*(const LAS unsigned short*)(p + (2 * q + 1) * PITCH) << 16);
    return __builtin_bit_cast(bf16x8, (u32x4){w[0], w[1], w[2], w[3]});
}
__device__ __forceinline__ bf16x8 ld_vT(const LAS unsigned char* p) { return ld_T<128>(p); }
#define TR16_ASM(o, b, HO, K2O, K2HO) asm volatile( \
    "ds_read_b64_tr_b16 %0, %16\n\tds_read_b64_tr_b16 %1, %16 offset:" #HO "\n\tds_read_b64_tr_b16 %2, %16 offset:" #K2O "\n\tds_read_b64_tr_b16 %3, %16 offset:" #K2HO "\n\t" \
    "ds_read_b64_tr_b16 %4, %17\n\tds_read_b64_tr_b16 %5, %17 offset:" #HO "\n\tds_read_b64_tr_b16 %6, %17 offset:" #K2O "\n\tds_read_b64_tr_b16 %7, %17 offset:" #K2HO "\n\t" \
    "ds_read_b64_tr_b16 %8, %18\n\tds_read_b64_tr_b16 %9, %18 offset:" #HO "\n\tds_read_b64_tr_b16 %10, %18 offset:" #K2O "\n\tds_read_b64_tr_b16 %11, %18 offset:" #K2HO "\n\t" \
    "ds_read_b64_tr_b16 %12, %19\n\tds_read_b64_tr_b16 %13, %19 offset:" #HO "\n\tds_read_b64_tr_b16 %14, %19 offset:" #K2O "\n\tds_read_b64_tr_b16 %15, %19 offset:" #K2HO "\n\t" \
    "s_waitcnt lgkmcnt(0)" \
    : "=&v"(o[0]), "=&v"(o[1]), "=&v"(o[2]), "=&v"(o[3]), "=&v"(o[4]), "=&v"(o[5]), "=&v"(o[6]), "=&v"(o[7]), "=&v"(o[8]), "=&v"(o[9]), "=&v"(o[10]), "=&v"(o[11]), "=&v"(o[12]), "=&v"(o[13]), "=&v"(o[14]), "=&v"(o[15]) \
    : "v"(b[0]), "v"(b[1]), "v"(b[2]), "v"(b[3]) : "memory")
#define TR16_FRAG(o, XI, KI) __builtin_bit_cast(bf16x8, (u32x4){o[4 * (XI) + 2 * (KI)][0], o[4 * (XI) + 2 * (KI)][1], o[4 * (XI) + 2 * (KI) + 1][0], o[4 * (XI) + 2 * (KI) + 1][1]})
constexpr int S_STR = 272;
constexpr int S_BUF64 = 64 * S_STR;
struct HgO { bf16x8 q[4]; u32x2 o[4]; bf16x8 v[2]; };
struct HgS { bf16x8 k[2][2]; f32x4 a[2]; };
constexpr int L_HV = 2 * S_BUF64;
template <int DIR>
__device__ __forceinline__ void hgrn_p2b(const bf16_t* Qg, const bf16_t* Kd, const bf16_t* VT, bf16_t* O, const float* av, LAS unsigned char* lds) {
    int tid = threadIdx.x; asm volatile("" : "+v"(tid));
    const int lane = tid & 63, wave = __builtin_amdgcn_readfirstlane(tid >> 6), role = wave >> 2, w4 = wave & 3, l15 = lane & 15, kg = lane >> 4;
    const int bx = blockIdx.x & 7;
    const int by = (blockIdx.x >> 3) & 15;
    const int dvh = by & 1, bh = bx + 8 * (by >> 2), b = bh >> 3, h = bh & 7;
    for (int i = tid; i < 2 * S_BUF64 / 4; i += 512) ((LAS unsigned*)lds)[i] = 0u;
    __syncthreads();
    const size_t fo_ = ((size_t)b * SEQ + kg) * DM + h * 128 + l15 * 8;
#define HG_N(i) (DIR ? 127 - (i) : (i))
    if (role == 0) {
        const bf16_t* qb = Qg + fo_ + (size_t)(16 * w4) * DM;
        bf16_t* ob = O + ((size_t)b * SEQ + 16 * w4 + l15) * DM + h * 128 + 64 * dvh + 4 * kg;
        const bf16_t* vb = VT + ((size_t)b * SEQ + 16 * w4 + (lane >> 3)) * DM + h * 128 + 64 * dvh + (lane & 7) * 8;
        LAS unsigned char* vl = lds + L_HV + (16 * w4 + (lane >> 3)) * 128;
#define HGO_LOAD(dst, n) do { const size_t c_ = (size_t)(64 * (n)) * DM; \
        _Pragma("unroll") for (int u = 0; u < 2; ++u) dst.v[u] = *(const bf16x8*)(vb + c_ + (size_t)(8 * u) * DM); \
        if (!DIR) { _Pragma("unroll") for (int mm = 0; mm < 4; ++mm) dst.o[mm] = *(const u32x2*)(ob + c_ + 16 * mm); } \
        _Pragma("unroll") for (int ks = 0; ks < 4; ++ks) dst.q[ks] = *(const bf16x8*)(qb + c_ + (size_t)(4 * ks) * DM); } while (0)
#define HGO_STEP(cur, mid, far, i) do { const int bufc = (i) & 1; \
        if ((i) + 2 < 128) HGO_LOAD(far, HG_N((i) + 2)); \
        if ((i) + 1 < 128) { _Pragma("unroll") for (int u = 0; u < 2; ++u) *(LAS bf16x8*)(vl + (bufc ^ 1) * 8192 + u * 1024 + (((lane & 7) ^ (2 * u)) << 4)) = mid.v[u]; } \
        f32x4 acco[4]; \
        _Pragma("unroll") for (int mm = 0; mm < 4; ++mm) acco[mm] = (f32x4){0.f, 0.f, 0.f, 0.f}; \
        _Pragma("unroll") for (int ks = 0; ks < 4; ++ks) _Pragma("unroll") for (int mm = 0; mm < 4; ++mm) { \
            const bf16x8 sf = *(const LAS bf16x8*)(lds + bufc * S_BUF64 + (16 * mm + l15) * S_STR + (ks * 32 + 8 * kg) * 2); \
            acco[mm] = __builtin_amdgcn_mfma_f32_16x16x32_bf16(sf, cur.q[ks], acco[mm], 0, 0, 0); } \
        bf16_t* op = ob + (size_t)(64 * HG_N(i)) * DM; \
        _Pragma("unroll") for (int mm = 0; mm < 4; ++mm) { \
            if (!DIR) *(u32x2*)(op + 16 * mm) = (u32x2){pk2(bflo(cur.o[mm].x) + acco[mm][0], bfhi(cur.o[mm].x) + acco[mm][1]), pk2(bflo(cur.o[mm].y) + acco[mm][2], bfhi(cur.o[mm].y) + acco[mm][3])}; \
            else      *(u32x2*)(op + 16 * mm) = (u32x2){pk2(acco[mm][0], acco[mm][1]), pk2(acco[mm][2], acco[mm][3])}; } \
        __syncthreads(); } while (0)
        HgO A, B, C;
#pragma unroll
        for (int mm = 0; mm < 4; ++mm) { A.o[mm] = (u32x2){0u, 0u}; B.o[mm] = A.o[mm]; C.o[mm] = A.o[mm]; }
        HGO_LOAD(A, HG_N(0)); HGO_LOAD(B, HG_N(1));
#pragma unroll
        for (int u = 0; u < 2; ++u) *(LAS bf16x8*)(vl + u * 1024 + (((lane & 7) ^ (2 * u)) << 4)) = A.v[u];
        __syncthreads();
        for (int i = 0; i < 126; i += 3) { HGO_STEP(A, B, C, i); HGO_STEP(B, C, A, i + 1); HGO_STEP(C, A, B, i + 2); }
        HGO_STEP(A, B, C, 126); HGO_STEP(B, C, A, 127);
#undef HGO_STEP
#undef HGO_LOAD
    } else {
        const bf16_t* kb = Kd + fo_ + (size_t)(16 * w4) * DM;
        const float* ab = av + (size_t)(b * 128) * DM + h * 128 + 32 * w4 + 4 * kg;
        unsigned vtr[4];
#pragma unroll
        for (int x = 0; x < 4; ++x) vtr[x] = (unsigned)(size_t)lds + L_HV + (8 * kg + (l15 >> 2)) * 128 + (((2 * x + ((l15 & 3) >> 1)) ^ (2 * (kg & 1))) << 4) + 8 * (l15 & 1);
        f32x4 accS[2][4];
#pragma unroll
        for (int m = 0; m < 2; ++m)
#pragma unroll
            for (int nn = 0; nn < 4; ++nn) accS[m][nn] = (f32x4){0.f, 0.f, 0.f, 0.f};
#define HGS_LOAD(dst, n) do { const size_t c_ = (size_t)(64 * (n)) * DM; \
        _Pragma("unroll") for (int m = 0; m < 2; ++m) _Pragma("unroll") for (int k2 = 0; k2 < 2; ++k2) dst.k[m][k2] = *(const bf16x8*)(kb + c_ + (size_t)(8 * m + 4 * k2) * DM); \
        _Pragma("unroll") for (int m = 0; m < 2; ++m) dst.a[m] = *(const f32x4*)(ab + (size_t)(n) * DM + 16 * m); } while (0)
#define HGS_STEP(cur, far, i) do { const int bufc = (i) & 1; \
        if ((i) + 2 < 128) HGS_LOAD(far, HG_N((i) + 2)); \
        u32x2 vo[16]; { unsigned vb_[4]; _Pragma("unroll") for (int x = 0; x < 4; ++x) vb_[x] = vtr[x] + bufc * 8192; TR16_ASM(vo, vb_, 512, 4096, 4608); } \
        _Pragma("unroll") for (int nn = 0; nn < 4; ++nn) { bf16x8 vf[2]; \
          _Pragma("unroll") for (int k2 = 0; k2 < 2; ++k2) vf[k2] = TR16_FRAG(vo, nn, k2); \
          _Pragma("unroll") for (int m = 0; m < 2; ++m) { accS[m][nn] = accS[m][nn] * cur.a[m]; \
            _Pragma("unroll") for (int k2 = 0; k2 < 2; ++k2) accS[m][nn] = __builtin_amdgcn_mfma_f32_16x16x32_bf16(cur.k[m][k2], vf[k2], accS[m][nn], 0, 0, 0); \
            *(LAS u32x2*)(lds + (bufc ^ 1) * S_BUF64 + (16 * nn + l15) * S_STR + (32 * w4 + 16 * m + 4 * kg) * 2) = (u32x2){pk2(accS[m][nn][0], accS[m][nn][1]), pk2(accS[m][nn][2], accS[m][nn][3])}; } } \
        __syncthreads(); } while (0)
        HgS A, B, C;
        HGS_LOAD(A, HG_N(0)); HGS_LOAD(B, HG_N(1));
        __syncthreads();
        for (int i = 0; i < 126; i += 3) { HGS_STEP(A, C, i); HGS_STEP(B, A, i + 1); HGS_STEP(C, B, i + 2); }
        HGS_STEP(A, C, 126); HGS_STEP(B, A, 127);
#undef HGS_STEP
#undef HGS_LOAD
    }
#undef HG_N
}

constexpr int F_TS = 256, F_TB = 64 * F_TS;
constexpr int L_FS = 0, L_FV = 2 * F_TB, L_FQT = L_FV + 2 * 8192, L_FKT = L_FQT + 2 * F_TB, L_FQG = L_FKT + 2 * F_TB, L_FSEG = L_FQG + 2 * F_TB, L_FAV = L_FSEG + 8 * 128 * 4, L_FET = L_FAV + 2 * 512, L_FEND = L_FET + 2 * 512;
static_assert(L_FEND <= LDS_XB, "fused HGRN pass LDS images overflow");
#define TR8_ASM(o, b, HO, K2O, K2HO) asm volatile( \
    "ds_read_b64_tr_b16 %0, %8\n\tds_read_b64_tr_b16 %1, %8 offset:" #HO "\n\tds_read_b64_tr_b16 %2, %8 offset:" #K2O "\n\tds_read_b64_tr_b16 %3, %8 offset:" #K2HO "\n\t" \
    "ds_read_b64_tr_b16 %4, %9\n\tds_read_b64_tr_b16 %5, %9 offset:" #HO "\n\tds_read_b64_tr_b16 %6, %9 offset:" #K2O "\n\tds_read_b64_tr_b16 %7, %9 offset:" #K2HO "\n\t" \
    "s_waitcnt lgkmcnt(0)" \
    : "=&v"(o[0]), "=&v"(o[1]), "=&v"(o[2]), "=&v"(o[3]), "=&v"(o[4]), "=&v"(o[5]), "=&v"(o[6]), "=&v"(o[7]) : "v"(b[0]), "v"(b[1]) : "memory")
#define TR8C_ASM(o, b, HO) asm volatile( \
    "ds_read_b64_tr_b16 %0, %8\n\tds_read_b64_tr_b16 %1, %8 offset:" #HO "\n\tds_read_b64_tr_b16 %2, %9\n\tds_read_b64_tr_b16 %3, %9 offset:" #HO "\n\t" \
    "ds_read_b64_tr_b16 %4, %10\n\tds_read_b64_tr_b16 %5, %10 offset:" #HO "\n\tds_read_b64_tr_b16 %6, %11\n\tds_read_b64_tr_b16 %7, %11 offset:" #HO "\n\t" \
    "s_waitcnt lgkmcnt(0)" \
    : "=&v"(o[0]), "=&v"(o[1]), "=&v"(o[2]), "=&v"(o[3]), "=&v"(o[4]), "=&v"(o[5]), "=&v"(o[6]), "=&v"(o[7]) : "v"(b[0]), "v"(b[1]), "v"(b[2]), "v"(b[3]) : "memory")
#define TR_PAIR(o, I) __builtin_bit_cast(bf16x8, (u32x4){o[2 * (I)][0], o[2 * (I)][1], o[2 * (I) + 1][0], o[2 * (I) + 1][1]})
#define TR8B_ASM(o, b, K2O) asm volatile( \
    "ds_read_b64_tr_b16 %0, %8\n\tds_read_b64_tr_b16 %1, %9\n\tds_read_b64_tr_b16 %2, %8 offset:" #K2O "\n\tds_read_b64_tr_b16 %3, %9 offset:" #K2O "\n\t" \
    "ds_read_b64_tr_b16 %4, %10\n\tds_read_b64_tr_b16 %5, %11\n\tds_read_b64_tr_b16 %6, %10 offset:" #K2O "\n\tds_read_b64_tr_b16 %7, %11 offset:" #K2O "\n\t" \
    "s_waitcnt lgkmcnt(0)" \
    : "=&v"(o[0]), "=&v"(o[1]), "=&v"(o[2]), "=&v"(o[3]), "=&v"(o[4]), "=&v"(o[5]), "=&v"(o[6]), "=&v"(o[7]) : "v"(b[0]), "v"(b[1]), "v"(b[2]), "v"(b[3]) : "memory")
struct HfIn { unsigned q[8], l[8]; bf16x8 v[2]; };
template <int DIR>
__device__ __forceinline__ void hgrn_fused(const bf16_t* Uq, const bf16_t* Ul, const bf16_t* Uv, bf16_t* O, LAS unsigned char* lds, const int bx) {
    int tid = threadIdx.x; asm volatile("" : "+v"(tid));
    const int lane = tid & 63, wave = __builtin_amdgcn_readfirstlane(tid >> 6), seg = wave, role = wave >> 2, w4 = wave & 3, l15 = lane & 15, kg = lane >> 4, dp = lane;
    const int by = (blockIdx.x >> 3) & 15;
    const int dvh = by & 1, bh = bx + 8 * (by >> 2), b = bh >> 3, h = bh & 7;
    for (int i = tid; i < 2 * F_TB / 4; i += 512) ((LAS unsigned*)(lds + L_FS))[i] = 0u;
    LAS float* SEG = (LAS float*)(lds + L_FSEG);
    const size_t eb = ((size_t)b * SEQ + 8 * seg) * DM + h * 128 + 2 * dp;
    const bf16_t* vb = Uv + ((size_t)b * SEQ + 16 * w4 + (lane >> 3)) * DM + h * 128 + 64 * dvh + (lane & 7) * 8;
    LAS unsigned char* vl = lds + L_FV + (16 * w4 + (lane >> 3)) * 128;
    bf16_t* ob = O + ((size_t)b * SEQ + 16 * w4 + l15) * DM + h * 128 + 64 * dvh + 4 * kg;
    const unsigned lds0 = (unsigned)(size_t)lds;
    int ew[8];
#pragma unroll
    for (int i8 = 0; i8 < 8; ++i8) { const int t = 8 * seg + i8; ew[i8] = t * F_TS + (((dp >> 2) ^ (t & 15)) << 4) + (dp & 3) * 4; }
#define HF_N(i) (DIR ? 127 - (i) : (i))
#define HF_LOAD(RC, dst, n) do { const size_t c_ = (size_t)(64 * (n)) * DM; \
        _Pragma("unroll") for (int i = 0; i < 8; ++i) { dst.q[i] = *(const unsigned*)(Uq + eb + c_ + (size_t)i * DM); dst.l[i] = *(const unsigned*)(Ul + eb + c_ + (size_t)i * DM); } \
        if (RC == 0) { _Pragma("unroll") for (int u = 0; u < 2; ++u) dst.v[u] = *(const bf16x8*)(vb + c_ + (size_t)(8 * u) * DM); } } while (0)
#define HF_VPUT(src, par) do { _Pragma("unroll") for (int u = 0; u < 2; ++u) *(LAS bf16x8*)(vl + (par) * 8192 + u * 1024 + (((lane & 7) ^ (2 * u)) << 4)) = src.v[u]; } while (0)
#define HF_E1(src) \
        { float r0 = 0.f, r1 = 0.f; \
          _Pragma("unroll") for (int i8 = 0; i8 < 8; ++i8) { r0 += bflo(src.l[i8]); r1 += bfhi(src.l[i8]); } \
          SEG[seg * 128 + 2 * dp] = r0; SEG[seg * 128 + 2 * dp + 1] = r1; }
#define HF_E2(src, par) do { \
          float off0 = 0.f, off1 = 0.f, m0 = 0.f, m1 = 0.f, tot0 = 0.f, tot1 = 0.f; \
          _Pragma("unroll") for (int s2 = 0; s2 < 8; ++s2) { const float x0 = SEG[s2 * 128 + 2 * dp], x1 = SEG[s2 * 128 + 2 * dp + 1]; \
              if (DIR ? (s2 > seg) : (s2 < seg)) { off0 += x0; off1 += x1; } if (DIR ? (s2 >= 4) : (s2 < 4)) { m0 += x0; m1 += x1; } tot0 += x0; tot1 += x1; } \
          const f32v2_t em = {__builtin_amdgcn_exp2f(m0), __builtin_amdgcn_exp2f(m1)}; const f32v2_t one = {1.f, 1.f}; \
          f32v2_t g = {off0 - m0, off1 - m1};        \
          _Pragma("unroll") for (int j8 = 0; j8 < 8; ++j8) { const int i8 = DIR ? 7 - j8 : j8; \
              const f32v2_t l = {bflo(src.l[i8]), bfhi(src.l[i8])}, q = {bflo(src.q[i8]), bfhi(src.q[i8])}; g += l; \
              const f32v2_t f = {__builtin_amdgcn_exp2f(l.x), __builtin_amdgcn_exp2f(l.y)}, k = one - f; \
              const f32v2_t gc = {__builtin_amdgcn_fmed3f(g.x, -115.f, 115.f), __builtin_amdgcn_fmed3f(g.y, -115.f, 115.f)}; \
              const f32v2_t e = {__builtin_amdgcn_exp2f(gc.x), __builtin_amdgcn_exp2f(gc.y)}, r = {__builtin_amdgcn_rcpf(e.x), __builtin_amdgcn_rcpf(e.y)}; \
              const f32v2_t qt = q * e, kt = k * r, qg = qt * em; \
              *(LAS unsigned*)(lds + L_FQT + (par) * F_TB + ew[i8]) = __builtin_bit_cast(unsigned, __builtin_convertvector(qt, bf16v2_t)); \
              *(LAS unsigned*)(lds + L_FKT + (par) * F_TB + ew[i8]) = __builtin_bit_cast(unsigned, __builtin_convertvector(kt, bf16v2_t)); \
              *(LAS unsigned*)(lds + L_FQG + (par) * F_TB + ew[i8]) = __builtin_bit_cast(unsigned, __builtin_convertvector(qg, bf16v2_t)); } \
          if (seg == 0) { LAS float* av_ = (LAS float*)(lds + L_FAV + (par) * 512); LAS float* et_ = (LAS float*)(lds + L_FET + (par) * 512); \
              av_[2 * dp] = __builtin_amdgcn_exp2f(tot0); av_[2 * dp + 1] = __builtin_amdgcn_exp2f(tot1); et_[2 * dp] = __builtin_amdgcn_exp2f(tot0 - m0); et_[2 * dp + 1] = __builtin_amdgcn_exp2f(tot1 - m1); } } while (0)
#define HF_MO(i, bufc) do { \
            f32x4 acco[4], accp[4]; \
            _Pragma("unroll") for (int mm = 0; mm < 4; ++mm) { acco[mm] = (f32x4){0.f, 0.f, 0.f, 0.f}; accp[mm] = acco[mm]; } \
            _Pragma("unroll") for (int ks = 0; ks < 4; ++ks) { \
                const bf16x8 qg = *(const LAS bf16x8*)(lds + L_FQG + (bufc) * F_TB + (16 * w4) * F_TS + ro[ks]); \
                _Pragma("unroll") for (int mm = 0; mm < 4; ++mm) { const bf16x8 sf = *(const LAS bf16x8*)(lds + L_FS + (bufc) * F_TB + (16 * mm) * F_TS + ro[ks]); \
                    acco[mm] = __builtin_amdgcn_mfma_f32_16x16x32_bf16(sf, qg, acco[mm], 0, 0, 0); } } \
            _Pragma("unroll") for (int si = 0; si < 4; ++si) { \
                if (DIR ? si >= w4 : si <= w4) { \
                    _Pragma("unroll") for (int ks = 0; ks < 4; ++ks) { const bf16x8 kt_ = *(const LAS bf16x8*)(lds + L_FKT + (bufc) * F_TB + (16 * si) * F_TS + ro[ks]); \
                        const bf16x8 qt_ = *(const LAS bf16x8*)(lds + L_FQT + (bufc) * F_TB + (16 * w4) * F_TS + ro[ks]); \
                        accp[si] = __builtin_amdgcn_mfma_f32_16x16x32_bf16(kt_, qt_, accp[si], 0, 0, 0); } \
                    if (si == w4) { _Pragma("unroll") for (int r = 0; r < 4; ++r) { const bool keep = DIR ? (4 * kg + r >= l15) : (4 * kg + r <= l15); accp[si][r] = keep ? accp[si][r] : 0.f; } } } } \
              \
            u32x2 oo[16]; { unsigned ob_[4]; _Pragma("unroll") for (int x = 0; x < 4; ++x) ob_[x] = otr[x] + (bufc) * 8192; TR16_ASM(oo, ob_, 2048, 4096, 6144); } \
            _Pragma("unroll") for (int kp = 0; kp < 2; ++kp) { \
                if (DIR ? (2 * kp + 1 >= w4) : (2 * kp <= w4)) { \
                    const bf16x8 pf = __builtin_bit_cast(bf16x8, (u32x4){pk2(accp[2 * kp][0], accp[2 * kp][1]), pk2(accp[2 * kp][2], accp[2 * kp][3]), pk2(accp[2 * kp + 1][0], accp[2 * kp + 1][1]), pk2(accp[2 * kp + 1][2], accp[2 * kp + 1][3])}); \
                    _Pragma("unroll") for (int mm = 0; mm < 4; ++mm) acco[mm] = __builtin_amdgcn_mfma_f32_16x16x32_bf16(TR16_FRAG(oo, mm, kp), pf, acco[mm], 0, 0, 0); } } \
            bf16_t* op = ob + (size_t)(64 * HF_N(i)) * DM; \
            _Pragma("unroll") for (int mm = 0; mm < 4; ++mm) *(u32x2*)(op + 16 * mm) = (u32x2){pk2(acco[mm][0], acco[mm][1]), pk2(acco[mm][2], acco[mm][3])}; } while (0)
#define HF_MS(bufc) do { \
            f32x4 av[2], et[2]; _Pragma("unroll") for (int m = 0; m < 2; ++m) { av[m] = *(const LAS f32x4*)(lds + L_FAV + (bufc) * 512 + (32 * w4 + 16 * m + 4 * kg) * 4); et[m] = *(const LAS f32x4*)(lds + L_FET + (bufc) * 512 + (32 * w4 + 16 * m + 4 * kg) * 4); } \
            u32x2 ko[8]; \
            { unsigned kb_[4]; _Pragma("unroll") for (int x = 0; x < 4; ++x) kb_[x] = ktr[x] + (bufc) * F_TB; TR8B_ASM(ko, kb_, 8192); } \
            u32x2 vo[16]; { unsigned vb_[4]; _Pragma("unroll") for (int x = 0; x < 4; ++x) vb_[x] = vtr[x] + (bufc) * 8192; TR16_ASM(vo, vb_, 512, 4096, 4608); } \
            { \
              _Pragma("unroll") for (int nn = 0; nn < 4; ++nn) _Pragma("unroll") for (int m = 0; m < 2; ++m) { f32x4 tmp = (f32x4){0.f, 0.f, 0.f, 0.f}; \
                _Pragma("unroll") for (int k2 = 0; k2 < 2; ++k2) tmp = __builtin_amdgcn_mfma_f32_16x16x32_bf16(TR16_FRAG(ko, m, k2), TR16_FRAG(vo, nn, k2), tmp, 0, 0, 0); \
                accS[m][nn] = accS[m][nn] * av[m] + tmp * et[m]; \
                *(LAS u32x2*)(lds + L_FS + ((bufc) ^ 1) * F_TB + (16 * nn) * F_TS + wo[m]) = (u32x2){pk2(accS[m][nn][0], accS[m][nn][1]), pk2(accS[m][nn][2], accS[m][nn][3])}; } } } while (0)
#define HF_STEP(RC, nx, ld, i) do { const int bufc = (i) & 1; \
        if ((i) + 2 < 128) HF_LOAD(RC, ld, HF_N((i) + 2)); \
        if ((i) + 1 < 128) { HF_E1(nx) \
            __syncthreads(); \
            if (RC == 0) { HF_VPUT(nx, bufc ^ 1); HF_E2(nx, bufc ^ 1); HF_MO(i, bufc); } else { HF_MS(bufc); HF_E2(nx, bufc ^ 1); } \
        } else { if (RC == 0) HF_MO(i, bufc); else HF_MS(bufc); } \
        __syncthreads(); } while (0)
    if (role == 0) {
        int ro[4];
#pragma unroll
        for (int ks = 0; ks < 4; ++ks) ro[ks] = l15 * F_TS + (((4 * ks + kg) ^ l15) << 4);
        unsigned otr[4];
#pragma unroll
        for (int x = 0; x < 4; ++x) otr[x] = lds0 + L_FV + (4 * kg + (l15 >> 2)) * 128 + (((2 * x + ((l15 & 3) >> 1)) ^ (2 * (kg >> 1))) << 4) + 8 * (l15 & 1);
        int wo[2] = {0, 0}; unsigned vtr[4] = {0u, 0u, 0u, 0u}, ktr[4] = {0u, 0u, 0u, 0u};
        f32x4 accS[2][4];
        HfIn A, B;
        HF_LOAD(0, A, HF_N(0)); HF_LOAD(0, B, HF_N(1));
        { HF_E1(A)
          __syncthreads();
          HF_E2(A, 0); HF_VPUT(A, 0); }
        __syncthreads();
        for (int i = 0; i < 128; i += 2) { HF_STEP(0, B, A, i); HF_STEP(0, A, B, i + 1); }
    } else {
        int wo[2];
#pragma unroll
        for (int m = 0; m < 2; ++m) wo[m] = l15 * F_TS + (((4 * w4 + 2 * m + (kg >> 1)) ^ l15) << 4) + ((kg & 1) << 3);
        unsigned vtr[4], ktr[4];
#pragma unroll
        for (int x = 0; x < 4; ++x) {
            vtr[x] = lds0 + L_FV + (8 * kg + (l15 >> 2)) * 128 + (((2 * x + ((l15 & 3) >> 1)) ^ (2 * (kg & 1))) << 4) + 8 * (l15 & 1);
            const int m = x >> 1, hf = x & 1, t = 8 * kg + 4 * hf + (l15 >> 2);
            ktr[x] = lds0 + L_FKT + t * F_TS + (((4 * w4 + 2 * m + ((l15 & 3) >> 1)) ^ (t & 15)) << 4) + 8 * (l15 & 1); }
        int ro[4] = {0, 0, 0, 0}; unsigned otr[4] = {0u, 0u, 0u, 0u};
        f32x4 accS[2][4];
#pragma unroll
        for (int m = 0; m < 2; ++m)
#pragma unroll
            for (int nn = 0; nn < 4; ++nn) accS[m][nn] = (f32x4){0.f, 0.f, 0.f, 0.f};
        HfIn A, B;
        HF_LOAD(1, A, HF_N(0)); HF_LOAD(1, B, HF_N(1));
        { HF_E1(A)
          __syncthreads();
          HF_E2(A, 0); }
        __syncthreads();
        for (int i = 0; i < 128; i += 2) { HF_STEP(1, B, A, i); HF_STEP(1, A, B, i + 1); }
    }
#undef HF_STEP
#undef HF_MS
#undef HF_MO
#undef HF_E2
#undef HF_E1
#undef HF_VPUT
#undef HF_LOAD
#undef HF_N
}

constexpr int RA_VT = 0, RA_A = 256 * 144;
__device__ __forceinline__ void ret_p2a(const bf16_t* Uq, const bf16_t* Uk, const bf16_t* Uv, bf16_t* Ukt, bf16_t* Uvt, bf16_t* Uo, LAS unsigned char* lds) {
    int tid = threadIdx.x; asm volatile("" : "+v"(tid));
    const int lane = tid & 63, wave = __builtin_amdgcn_readfirstlane(tid >> 6), l15 = lane & 15, kg = lane >> 4;
    const int dq = tid & 127, seg = wave >> 1;
    const int ti = wave & 3, sp = wave >> 2;
    unsigned wk[16], wv[16]; bf16x8 qf[8], kf[2][8];
#define RA_LOADE(tk) do { const int h_ = (tk) & 3, n_ = ((tk) >> 2) & 127, b_ = (tk) >> 9; const size_t R0_ = (size_t)b_ * SEQ + 64 * n_; \
        _Pragma("unroll") for (int i = 0; i < 16; ++i) { wv[i] = *(const unsigned*)(Uv + (R0_ + 16 * seg + i) * DM + h_ * 256 + 2 * dq); \
            const int f = 8 * seg + (dq >> 4), L = i + 16 * ((dq >> 2) & 3); \
            wk[i] = *(const unsigned*)(Uk + (R0_ + 2 * f + (L >> 5)) * DM + h_ * 256 + (L & 31) * 8 + 2 * (dq & 3)); } } while (0)
#define RA_LOADF(tk) do { const int h_ = (tk) & 3, n_ = ((tk) >> 2) & 127, b_ = (tk) >> 9; const size_t R0_ = (size_t)b_ * SEQ + 64 * n_; \
        _Pragma("unroll") for (int ks = 0; ks < 8; ++ks) { qf[ks] = *(const bf16x8*)(Uq + (R0_ + 2 * (8 * ti + ks) + (lane >> 5)) * DM + h_ * 256 + (lane & 31) * 8); \
            _Pragma("unroll") for (int u = 0; u < 2; ++u) kf[u][ks] = *(const bf16x8*)(Uk + (R0_ + 2 * (8 * (2 * sp + u) + ks) + (lane >> 5)) * DM + h_ * 256 + (lane & 31) * 8); } } while (0)
    if ((int)blockIdx.x < 4 * 128 * 4) { RA_LOADF((int)blockIdx.x); RA_LOADE((int)blockIdx.x); }
    for (int task = blockIdx.x; task < 4 * 128 * 4; task += gridDim.x) {
        const int h = task & 3, n = (task >> 2) & 127, b = task >> 9;
        const size_t R0 = (size_t)b * SEQ + 64 * n;
        const float lg = __log2f(1.0f - exp2f(-5.0f - (float)h));
        const bool more = task + (int)gridDim.x < 4 * 128 * 4;
        f32x4 accp[2];
#pragma unroll
        for (int u = 0; u < 2; ++u) accp[u] = (f32x4){0.f, 0.f, 0.f, 0.f};
#pragma unroll
        for (int ks = 0; ks < 8; ++ks)
#pragma unroll
            for (int u = 0; u < 2; ++u) accp[u] = __builtin_amdgcn_mfma_f32_16x16x32_bf16(kf[u][ks], qf[ks], accp[u], 0, 0, 0);
        if (more) RA_LOADF(task + (int)gridDim.x);
        __syncthreads();
#pragma unroll
        for (int u = 0; u < 2; ++u) { const int si = 2 * sp + u; const int t = 16 * ti + l15; float o4[4];
#pragma unroll
            for (int j = 0; j < 4; ++j) { const int sidx = 16 * si + 4 * kg + j; const int dd = t > sidx ? t - sidx : sidx - t; o4[j] = accp[u][j] * exp2f((float)dd * lg) * (dd == 0 ? 2.f : 1.f); }
            *(LAS u32x2*)(lds + RA_A + t * VT_STR + (16 * si + 4 * kg) * 2) = (u32x2){pk2(o4[0], o4[1]), pk2(o4[2], o4[3])}; }
        {
            unsigned kt0[8], kt1[8], vt0[8], vt1[8];
#pragma unroll
            for (int i2 = 0; i2 < 8; ++i2) {
                const unsigned ka = wk[2 * i2], kb = wk[2 * i2 + 1], va = wv[2 * i2], vb = wv[2 * i2 + 1];
                kt0[i2] = (ka & 0xffffu) | (kb << 16); kt1[i2] = (ka >> 16) | (kb & 0xffff0000u);
                vt0[i2] = (va & 0xffffu) | (vb << 16); vt1[i2] = (va >> 16) | (vb & 0xffff0000u);
            }
#define RA_ADDR(d, p) ((R0 + 2 * (((d) >> 4) * 2 + (seg >> 1)) + ((((d) & 15) + 16 * (2 * (seg & 1) + (p))) >> 5)) * DM + h * 256 + ((((d) & 15) + 16 * (2 * (seg & 1) + (p))) & 31) * 8)
            const int d0 = 2 * dq, d1 = d0 + 1;
            (void)Ukt;
            (void)Uvt;
#undef RA_ADDR
            LAS unsigned char* l0 = lds + RA_VT + (2 * dq) * VT_STR + 32 * seg;
            *(LAS u32x4*)(l0) = (u32x4){vt0[0], vt0[1], vt0[2], vt0[3]}; *(LAS u32x4*)(l0 + 16) = (u32x4){vt0[4], vt0[5], vt0[6], vt0[7]};
            *(LAS u32x4*)(l0 + VT_STR) = (u32x4){vt1[0], vt1[1], vt1[2], vt1[3]}; *(LAS u32x4*)(l0 + VT_STR + 16) = (u32x4){vt1[4], vt1[5], vt1[6], vt1[7]};
        }
        if (more) RA_LOADE(task + (int)gridDim.x);
        __syncthreads();
        {
            f32x4 acco[2][4];
#pragma unroll
            for (int u = 0; u < 2; ++u)
#pragma unroll
                for (int t4 = 0; t4 < 4; ++t4) acco[u][t4] = (f32x4){0.f, 0.f, 0.f, 0.f};
#pragma unroll
            for (int k2 = 0; k2 < 2; ++k2) { const int ko = (k2 * 32 + 8 * kg) * 2;
                bf16x8 a_[4];
#pragma unroll
                for (int t4 = 0; t4 < 4; ++t4) a_[t4] = *(const LAS bf16x8*)(lds + RA_A + (16 * t4 + l15) * VT_STR + ko);
#pragma unroll
                for (int u = 0; u < 2; ++u) { const bf16x8 vt_ = *(const LAS bf16x8*)(lds + RA_VT + (16 * (2 * wave + u) + l15) * VT_STR + ko);
#pragma unroll
                    for (int t4 = 0; t4 < 4; ++t4) acco[u][t4] = __builtin_amdgcn_mfma_f32_16x16x32_bf16(vt_, a_[t4], acco[u][t4], 0, 0, 0); } }
#pragma unroll
            for (int u = 0; u < 2; ++u)
#pragma unroll
                for (int t4 = 0; t4 < 4; ++t4) *(u32x2*)(Uo + (R0 + 16 * t4 + l15) * DM + h * 256 + 16 * (2 * wave + u) + 4 * kg) = (u32x2){pk2(acco[u][t4][0], acco[u][t4][1]), pk2(acco[u][t4][2], acco[u][t4][3])};
        }
    }
}
constexpr int R_STR = 528, R_BUF64 = 64 * 528;
struct RtO { bf16x8 q[8]; u32x4 v[2]; };
struct RtS { bf16x8 k[8]; };
constexpr int L_RK = 2 * R_BUF64;
constexpr int L_RV = 4 * R_BUF64;
template <int DIR>
__device__ __forceinline__ void ret_p2b(const bf16_t* Q, const bf16_t* KT, const bf16_t* VT, bf16_t* O, LAS unsigned char* lds, const int bx) {
    int tid = threadIdx.x; asm volatile("" : "+v"(tid));
    const int lane = tid & 63, wave = __builtin_amdgcn_readfirstlane(tid >> 6), role = wave >> 2, w4 = wave & 3, l15 = lane & 15, kg = lane >> 4;
    const int by = (blockIdx.x >> 3) & 15;
    const int dvq = by & 3, bh = bx + 8 * (by >> 3), b = bh >> 2, h = bh & 3;
    for (int i = tid; i < 2 * R_BUF64 / 4; i += 512) ((LAS unsigned*)lds)[i] = 0u;
    __syncthreads();
    const float lg = __log2f(1.0f - exp2f(-5.0f - (float)h));
    const size_t fo_ = ((size_t)b * SEQ + (lane >> 5)) * DM + h * 256 + (lane & 31) * 8;
#define RT_N(i) (DIR ? 127 - (i) : (i))
    if (role == 0) {
        const float rs = DIR ? exp2f((float)(64 - (16 * w4 + l15)) * lg) : exp2f((float)(16 * w4 + l15 + 1) * lg);
        const float g64i = exp2f(-64.f * lg);
        const bf16_t* qb = Q + fo_ + (size_t)(16 * w4) * DM;
        bf16_t* ob = O + ((size_t)b * SEQ + 16 * w4 + l15) * DM + h * 256 + 64 * dvq + 4 * kg;
        const bf16_t* vb = VT + ((size_t)b * SEQ + 16 * w4 + (lane >> 3)) * DM + h * 256 + 64 * dvq + (lane & 7) * 8;
        LAS unsigned char* vl = lds + L_RV + (16 * w4 + (lane >> 3)) * 128;
        float vs[2];
#pragma unroll
        for (int u = 0; u < 2; ++u) { const int t = 16 * w4 + 8 * u + (lane >> 3); vs[u] = exp2f((float)(DIR ? t : 63 - t) * lg); }
        unsigned otr[4];
#pragma unroll
        for (int x = 0; x < 4; ++x) otr[x] = (unsigned)(size_t)lds + L_RV + (4 * kg + (l15 >> 2)) * 128 + (((2 * x + ((l15 & 3) >> 1)) ^ (2 * (kg >> 1))) << 4) + 8 * (l15 & 1);
#define RTO_VPUT(src, par) do { _Pragma("unroll") for (int u = 0; u < 2; ++u) { const u32x4 raw = src.v[u]; u32x4 sc; \
            sc.x = pk2(bflo(raw.x) * vs[u], bfhi(raw.x) * vs[u]); sc.y = pk2(bflo(raw.y) * vs[u], bfhi(raw.y) * vs[u]); \
            sc.z = pk2(bflo(raw.z) * vs[u], bfhi(raw.z) * vs[u]); sc.w = pk2(bflo(raw.w) * vs[u], bfhi(raw.w) * vs[u]); \
            *(LAS u32x4*)(vl + (par) * 8192 + u * 1024 + (((lane & 7) ^ (2 * u)) << 4)) = sc; } } while (0)
#define RTO_LOAD(dst, n) do { const size_t c_ = (size_t)(64 * (n)) * DM; \
        _Pragma("unroll") for (int u = 0; u < 2; ++u) dst.v[u] = *(const u32x4*)(vb + c_ + (size_t)(8 * u) * DM); \
        _Pragma("unroll") for (int ks = 0; ks < 8; ++ks) dst.q[ks] = *(const bf16x8*)(qb + c_ + (size_t)(2 * ks) * DM); } while (0)
#define RTO_STEP(cur, mid, far, i) do { const int bufc = (i) & 1; \
        if ((i) + 2 < 128) RTO_LOAD(far, RT_N((i) + 2)); \
        if ((i) + 1 < 128) RTO_VPUT(mid, bufc ^ 1); \
        f32x4 acco[4]; \
        _Pragma("unroll") for (int mm = 0; mm < 4; ++mm) acco[mm] = (f32x4){0.f, 0.f, 0.f, 0.f}; \
        _Pragma("unroll") for (int ks = 0; ks < 8; ++ks) _Pragma("unroll") for (int mm = 0; mm < 4; ++mm) { \
            const bf16x8 sf = *(const LAS bf16x8*)(lds + bufc * R_BUF64 + (16 * mm + l15) * R_STR + (ks * 32 + 8 * kg) * 2); \
            acco[mm] = __builtin_amdgcn_mfma_f32_16x16x32_bf16(sf, cur.q[ks], acco[mm], 0, 0, 0); } \
        f32x4 accp[4]; \
        _Pragma("unroll") for (int si = 0; si < 4; ++si) { accp[si] = (f32x4){0.f, 0.f, 0.f, 0.f}; \
            if (DIR ? si >= w4 : si <= w4) { const int tr_ = 16 * si + l15; const int sw_ = 2 * ((tr_ >> 3) & 3); \
                const LAS unsigned char* kr_ = lds + L_RK + bufc * R_BUF64 + tr_ * R_STR; \
                _Pragma("unroll") for (int ks = 0; ks < 8; ++ks) { const bf16x8 kf_ = *(const LAS bf16x8*)(kr_ + (((4 * ks + kg) ^ sw_) << 4)); \
                    accp[si] = __builtin_amdgcn_mfma_f32_16x16x32_bf16(kf_, cur.q[ks], accp[si], 0, 0, 0); } \
                if (si == w4) { _Pragma("unroll") for (int r = 0; r < 4; ++r) { const bool keep = DIR ? (4 * kg + r >= l15) : (4 * kg + r <= l15); accp[si][r] = keep ? accp[si][r] : 0.f; } } \
                accp[si] = accp[si] * g64i; } } \
        u32x2 oo[16]; { unsigned ob_[4]; _Pragma("unroll") for (int x = 0; x < 4; ++x) ob_[x] = otr[x] + bufc * 8192; TR16_ASM(oo, ob_, 2048, 4096, 6144); } \
        _Pragma("unroll") for (int kp = 0; kp < 2; ++kp) { \
            if (DIR ? (2 * kp + 1 >= w4) : (2 * kp <= w4)) { \
                const bf16x8 pf = __builtin_bit_cast(bf16x8, (u32x4){pk2(accp[2 * kp][0], accp[2 * kp][1]), pk2(accp[2 * kp][2], accp[2 * kp][3]), pk2(accp[2 * kp + 1][0], accp[2 * kp + 1][1]), pk2(accp[2 * kp + 1][2], accp[2 * kp + 1][3])}); \
                _Pragma("unroll") for (int mm = 0; mm < 4; ++mm) { const bf16x8 vt_ = TR16_FRAG(oo, mm, kp); \
                    acco[mm] = __builtin_amdgcn_mfma_f32_16x16x32_bf16(vt_, pf, acco[mm], 0, 0, 0); } } } \
        bf16_t* op = ob + (size_t)(64 * RT_N(i)) * DM; \
        _Pragma("unroll") for (int mm = 0; mm < 4; ++mm) \
            *(u32x2*)(op + 16 * mm) = (u32x2){pk2(acco[mm][0] * rs, acco[mm][1] * rs), pk2(acco[mm][2] * rs, acco[mm][3] * rs)}; \
        __syncthreads(); } while (0)
        RtO A, B, C;
        RTO_LOAD(A, RT_N(0)); RTO_LOAD(B, RT_N(1));
        RTO_VPUT(A, 0);
        __syncthreads();
        for (int i = 0; i < 126; i += 3) { RTO_STEP(A, B, C, i); RTO_STEP(B, C, A, i + 1); RTO_STEP(C, A, B, i + 2); }
        RTO_STEP(A, B, C, 126); RTO_STEP(B, C, A, 127);
#undef RTO_STEP
#undef RTO_VPUT
#undef RTO_LOAD
    } else {
        const float cd = exp2f(64.f * lg);
        const bf16_t* kb = KT + fo_ + (size_t)(16 * w4) * DM;
        const int tq = 16 * w4 + (lane & 15), ksw = 2 * ((tq >> 3) & 3);
        LAS unsigned char* kw = lds + L_RK + tq * R_STR;
        const unsigned lds0 = (unsigned)(size_t)lds;
        unsigned vtr[4], ktr[4];
#pragma unroll
        for (int x = 0; x < 4; ++x) {
            vtr[x] = lds0 + L_RV + (8 * kg + (l15 >> 2)) * 128 + (((2 * x + ((l15 & 3) >> 1)) ^ (2 * (kg & 1))) << 4) + 8 * (l15 & 1);
            ktr[x] = lds0 + L_RK + (8 * kg + (l15 >> 2)) * R_STR + ((8 * w4 + 2 * (x ^ kg) + ((l15 & 3) >> 1)) << 4) + 8 * (l15 & 1); }
        f32x4 accS[4][4];
#pragma unroll
        for (int m = 0; m < 4; ++m)
#pragma unroll
            for (int nn = 0; nn < 4; ++nn) accS[m][nn] = (f32x4){0.f, 0.f, 0.f, 0.f};
#define RTS_LOAD(dst, n) do { const size_t c_ = (size_t)(64 * (n)) * DM; \
        _Pragma("unroll") for (int j = 0; j < 8; ++j) dst.k[j] = *(const bf16x8*)(kb + c_ + (size_t)(2 * j) * DM); } while (0)
#define RTS_KPUT(src, par) do { _Pragma("unroll") for (int j = 0; j < 8; ++j) *(LAS bf16x8*)(kw + (par) * R_BUF64 + (((4 * j + (lane >> 4)) ^ ksw) << 4)) = src.k[j]; } while (0)
#define RTS_STEP(ld, put, i) do { const int bufc = (i) & 1; \
        if ((i) + 2 < 128) RTS_LOAD(ld, RT_N((i) + 2)); \
        if ((i) + 1 < 128) RTS_KPUT(put, bufc ^ 1); \
        u32x2 ko[16], vo[16];        \
        { unsigned kb_[4], vb_[4]; _Pragma("unroll") for (int x = 0; x < 4; ++x) { kb_[x] = ktr[x] + bufc * R_BUF64; vb_[x] = vtr[x] + bufc * 8192; } \
          TR16_ASM(ko, kb_, 2112, 16896, 19008); TR16_ASM(vo, vb_, 512, 4096, 4608); } \
        _Pragma("unroll") for (int nn = 0; nn < 4; ++nn) { bf16x8 vc[2]; \
            _Pragma("unroll") for (int k2 = 0; k2 < 2; ++k2) vc[k2] = TR16_FRAG(vo, nn, k2); \
            _Pragma("unroll") for (int m = 0; m < 4; ++m) { accS[m][nn] = accS[m][nn] * cd; \
                _Pragma("unroll") for (int k2 = 0; k2 < 2; ++k2) accS[m][nn] = __builtin_amdgcn_mfma_f32_16x16x32_bf16(TR16_FRAG(ko, m, k2), vc[k2], accS[m][nn], 0, 0, 0); \
                *(LAS u32x2*)(lds + (bufc ^ 1) * R_BUF64 + (16 * nn + l15) * R_STR + (64 * w4 + 16 * m + 4 * kg) * 2) = (u32x2){pk2(accS[m][nn][0], accS[m][nn][1]), pk2(accS[m][nn][2], accS[m][nn][3])}; } } \
        __syncthreads(); } while (0)
        RtS A, B;
        RTS_LOAD(A, RT_N(0)); RTS_LOAD(B, RT_N(1));
        RTS_KPUT(A, 0);
        __syncthreads();
        for (int i = 0; i < 128; i += 2) { RTS_STEP(A, B, i); RTS_STEP(B, A, i + 1); }
#undef RTS_STEP
#undef RTS_KPUT
#undef RTS_LOAD
    }
#undef RT_N
}
template <int HD, bool TWO>
__device__ __forceinline__ void p2c_norm_gate(const bf16_t* of, const bf16_t* ob, const bf16_t* gate, const float* g, bf16_t* dst, const bf16_t* gate_lo = nullptr, int split = 0) {
    int tid = threadIdx.x; asm volatile("" : "+v"(tid));
    const int lane = tid & 63, gw = blockIdx.x * 8 + (tid >> 6), NGW = gridDim.x * 8;
    float gv[16];
#pragma unroll
    for (int j = 0; j < 16; ++j) gv[j] = g[lane * 16 + j];
    u32x4 ra[6], rb[6];
#define PC_LOAD(rs_, row) do { const size_t o_ = (size_t)(row) * DM + lane * 16; rs_[0] = *(const u32x4*)(of + o_); rs_[1] = *(const u32x4*)(of + o_ + 8); \
        if (TWO) { rs_[4] = *(const u32x4*)(ob + o_); rs_[5] = *(const u32x4*)(ob + o_ + 8); } else { rs_[4] = (u32x4){0u, 0u, 0u, 0u}; rs_[5] = rs_[4]; } \
        const bf16_t* gt_ = ((row) < split) ? gate_lo : gate;                   \
        rs_[2] = *(const u32x4*)(gt_ + o_); rs_[3] = *(const u32x4*)(gt_ + o_ + 8); } while (0)
#define PC_PROC(rs_, row) do { const size_t o = (size_t)(row) * DM + lane * 16; \
        float v[16]; const unsigned aw[8] = {rs_[0].x, rs_[0].y, rs_[0].z, rs_[0].w, rs_[1].x, rs_[1].y, rs_[1].z, rs_[1].w}; \
        const unsigned gwd[8] = {rs_[2].x, rs_[2].y, rs_[2].z, rs_[2].w, rs_[3].x, rs_[3].y, rs_[3].z, rs_[3].w}; \
        float ss = 0.f; \
        const unsigned bw[8] = {rs_[4].x, rs_[4].y, rs_[4].z, rs_[4].w, rs_[5].x, rs_[5].y, rs_[5].z, rs_[5].w}; \
        _Pragma("unroll") for (int j = 0; j < 8; ++j) { v[2 * j] = bflo(aw[j]); v[2 * j + 1] = bfhi(aw[j]); if (TWO) { v[2 * j] += bflo(bw[j]); v[2 * j + 1] += bfhi(bw[j]); } ss += v[2 * j] * v[2 * j] + v[2 * j + 1] * v[2 * j + 1]; } \
        ss = (HD == 128) ? sum_lanes8(ss) : sum_lanes16(ss); \
        const float rs = rsqrtf(ss * (1.0f / HD) + RMS_EPS); \
        unsigned ow[8]; \
        _Pragma("unroll") for (int j = 0; j < 8; ++j) ow[j] = pk2(v[2 * j] * rs * gv[2 * j] * bflo(gwd[j]), v[2 * j + 1] * rs * gv[2 * j + 1] * bfhi(gwd[j])); \
        *(u32x4*)(dst + o) = (u32x4){ow[0], ow[1], ow[2], ow[3]}; *(u32x4*)(dst + o + 8) = (u32x4){ow[4], ow[5], ow[6], ow[7]}; } while (0)
    if (gw < T_TOK) PC_LOAD(ra, gw);
    for (int row = gw; row < T_TOK; row += 2 * NGW) {
        const int r1 = row + NGW, r2 = row + 2 * NGW;
        if (r1 < T_TOK) PC_LOAD(rb, r1);
        PC_PROC(ra, row);
        if (r2 < T_TOK) PC_LOAD(ra, r2);
        if (r1 < T_TOK) PC_PROC(rb, r1);
    }
#undef PC_LOAD
#undef PC_PROC
}

constexpr int P5_XS = 2064;
constexpr int P5_XH = 0, P5_XL = 16 * P5_XS, P5_PART = 2 * 16 * P5_XS, P5_LOG = P5_PART + 8 * 16 * 48 * 4, P5_END = P5_LOG + 128 * 40 * 4;
__device__ __forceinline__ void p5_router(const Params& p, LAS unsigned char* lds) {
    int tid = threadIdx.x; asm volatile("" : "+v"(tid));
    const int lane = tid & 63, wave = __builtin_amdgcn_readfirstlane(tid >> 6), l15 = lane & 15, kg = lane >> 4;
    float* x1 = p.out; bf16_t* x1b = (bf16_t*)(p.ws + OFF_U0 + 3 * USTR);
    const float* wrt = (const float*)(p.ws + OFF_WRT);
    LAS int* ent_e = (LAS int*)(lds + LDS_MISC); LAS float* ent_w = (LAS float*)(lds + LDS_MISC + 1024);
    LAS int* ecnt = (LAS int*)(lds + LDS_MISC + 3072); LAS int* ebase = ecnt + 32;
    LAS float* PART = (LAS float*)(lds + P5_PART); LAS float* LOG = (LAS float*)(lds + P5_LOG);
    int* gcnt = (int*)(p.ws + OFF_GCNT); int* lent = (int*)(p.ws + OFF_LENT); float* lw = (float*)(p.ws + OFF_LW);
    f32x4 g4[4], b4[4];
#pragma unroll
    for (int j = 0; j < 4; ++j) { g4[j] = *(const f32x4*)(p.ln1_g + 4 * lane + 256 * j); b4[j] = *(const f32x4*)(p.ln1_b + 4 * lane + 256 * j); }
    bf16x8 wh[3][4], wlo[3][4];
#pragma unroll
    for (int nt = 0; nt < 3; ++nt)
#pragma unroll
        for (int ks = 0; ks < 4; ++ks) {
            const int o = 16 * nt + l15; f32x4 a = (f32x4){0.f, 0.f, 0.f, 0.f}, c = a;
            if (o < 36) { const float* wp = wrt + (size_t)o * 1024 + 128 * wave + 32 * ks + 8 * kg; a = *(const f32x4*)wp; c = *(const f32x4*)(wp + 4); }
            u32x4 hi; hi.x = pk2(a[0], a[1]); hi.y = pk2(a[2], a[3]); hi.z = pk2(c[0], c[1]); hi.w = pk2(c[2], c[3]);
            u32x4 lo; lo.x = pk2(a[0] - bflo(hi.x), a[1] - bfhi(hi.x)); lo.y = pk2(a[2] - bflo(hi.y), a[3] - bfhi(hi.y));
            lo.z = pk2(c[0] - bflo(hi.z), c[1] - bfhi(hi.z)); lo.w = pk2(c[2] - bflo(hi.w), c[3] - bfhi(hi.w));
            wh[nt][ks] = __builtin_bit_cast(bf16x8, hi); wlo[nt][ks] = __builtin_bit_cast(bf16x8, lo);
        }
    for (int tg = blockIdx.x; tg < T_TOK / 128; tg += gridDim.x) {
        if (tid < 32) ecnt[tid] = 0;
        f32x4 rowv[2][4];
#pragma unroll
        for (int r = 0; r < 2; ++r)
#pragma unroll
            for (int j = 0; j < 4; ++j) rowv[r][j] = ((const f32x4*)(x1 + (size_t)(tg * 128 + 2 * wave + r) * DM) + lane)[64 * j];
        for (int g = 0; g < 8; ++g) {
#pragma unroll
            for (int r = 0; r < 2; ++r) {
                const int lt = 16 * g + 2 * wave + r, token = tg * 128 + lt;
                f32x4 v[4]; float sm = 0.f;
#pragma unroll
                for (int j = 0; j < 4; ++j) { v[j] = rowv[r][j]; sm += (v[j][0] + v[j][1]) + (v[j][2] + v[j][3]); }
                const float mean = wave_sum(sm) * (1.f / DM); float s2 = 0.f;
#pragma unroll
                for (int j = 0; j < 4; ++j) { v[j] = v[j] - mean; s2 += (v[j][0] * v[j][0] + v[j][1] * v[j][1]) + (v[j][2] * v[j][2] + v[j][3] * v[j][3]); }
                const float rstd = rsqrtf(wave_sum(s2) * (1.f / DM) + LN_EPS);
#pragma unroll
                for (int j = 0; j < 4; ++j) { v[j] = v[j] * rstd * g4[j] + b4[j];
                    u32x2 hi; hi.x = pk2(v[j][0], v[j][1]); hi.y = pk2(v[j][2], v[j][3]);
                    *(u32x2*)(x1b + (size_t)token * DM + 4 * lane + 256 * j) = hi;
                    u32x2 lo; lo.x = pk2(v[j][0] - bflo(hi.x), v[j][1] - bfhi(hi.x)); lo.y = pk2(v[j][2] - bflo(hi.y), v[j][3] - bfhi(hi.y));
                    const int xo = (2 * wave + r) * P5_XS + (4 * lane + 256 * j) * 2;
                    *(LAS u32x2*)(lds + P5_XH + xo) = hi; *(LAS u32x2*)(lds + P5_XL + xo) = lo; }
            }
            if (g + 1 < 8) {
#pragma unroll
                for (int r = 0; r < 2; ++r)
#pragma unroll
                    for (int j = 0; j < 4; ++j) rowv[r][j] = ((const f32x4*)(x1 + (size_t)(tg * 128 + 16 * (g + 1) + 2 * wave + r) * DM) + lane)[64 * j];
            }
            __syncthreads();
            f32x4 acc[3];
#pragma unroll
            for (int nt = 0; nt < 3; ++nt) acc[nt] = (f32x4){0.f, 0.f, 0.f, 0.f};
#pragma unroll
            for (int ks = 0; ks < 4; ++ks) { const int ao = l15 * P5_XS + (128 * wave + 32 * ks + 8 * kg) * 2;
                const bf16x8 ah = *(const LAS bf16x8*)(lds + P5_XH + ao), al = *(const LAS bf16x8*)(lds + P5_XL + ao);
#pragma unroll
                for (int nt = 0; nt < 3; ++nt) { acc[nt] = __builtin_amdgcn_mfma_f32_16x16x32_bf16(ah, wh[nt][ks], acc[nt], 0, 0, 0);
                    acc[nt] = __builtin_amdgcn_mfma_f32_16x16x32_bf16(al, wh[nt][ks], acc[nt], 0, 0, 0);
                    acc[nt] = __builtin_amdgcn_mfma_f32_16x16x32_bf16(ah, wlo[nt][ks], acc[nt], 0, 0, 0); } }
#pragma unroll
            for (int nt = 0; nt < 3; ++nt)
#pragma unroll
                for (int j = 0; j < 4; ++j) PART[(wave * 16 + 4 * kg + j) * 48 + 16 * nt + l15] = acc[nt][j];
            __syncthreads();
            for (int e = tid; e < 16 * 36; e += 512) { const int tk = e / 36, o = e % 36; float a = (o < 4) ? p.b_group[o] : p.b_router[o - 4];
#pragma unroll
                for (int w8 = 0; w8 < 8; ++w8) a += PART[(w8 * 16 + tk) * 48 + o];
                LOG[(16 * g + tk) * 40 + o] = a; }
        }
        __syncthreads();
        {
            if (tid < 128) {
                const LAS float* lg = LOG + tid * 40; const int lt = tid;
                int grp = 0; float gmax = lg[0];
#pragma unroll
                for (int j = 1; j < 4; ++j) { if (lg[j] > gmax) { gmax = lg[j]; grp = j; } }
                float gden = 0.f;
#pragma unroll
                for (int j = 0; j < 4; ++j) gden += __expf(lg[j] - gmax);
                const float pgrp = 1.0f / gden;
                float el[8];
#pragma unroll
                for (int i = 0; i < 8; ++i) el[i] = lg[4 + grp * 8 + i];
                int i1 = 0; float m1 = el[0];
#pragma unroll
                for (int i = 1; i < 8; ++i) { if (el[i] > m1) { m1 = el[i]; i1 = i; } }
                int i2 = (i1 == 0) ? 1 : 0; float m2 = (i1 == 0) ? el[1] : el[0];
#pragma unroll
                for (int i = 1; i < 8; ++i) { if (i != i1 && el[i] > m2) { m2 = el[i]; i2 = i; } }
                const float w1 = 1.0f / (1.0f + __expf(m2 - m1)), w2 = 1.0f - w1;
                ent_e[2 * lt] = grp * 8 + i1; ent_w[2 * lt] = pgrp * w1; ent_e[2 * lt + 1] = grp * 8 + i2; ent_w[2 * lt + 1] = pgrp * w2;
            }
        }
        __syncthreads();
        int e = 0, r = 0;
        if (tid < 256) { e = ent_e[tid]; r = atomicAdd((int*)&ecnt[e], 1); }
        __syncthreads();
        if (tid < 32) ebase[tid] = atomicAdd(&gcnt[tid], ecnt[tid]);
        __syncthreads();
        if (tid < 256) { const int pos = ebase[e] + r; lent[(size_t)e * LCAP + pos] = (tg * 128 + (tid >> 1)) * 2 + (tid & 1); lw[(size_t)e * LCAP + pos] = ent_w[tid]; }
        __syncthreads();
    }
    {
        LAS float* scr = (LAS float*)(lds + wave * 16384);
        bf16_t* W13 = (bf16_t*)(p.ws + OFF_U0 + 4 * USTR); bf16_t* W2T = (bf16_t*)(p.ws + OFF_U0 + 5 * USTR);
        const int gw = blockIdx.x * 8 + wave, NGW = gridDim.x * 8;
        (void)W2T;
        for (int it = gw; it < 32 * 512; it += NGW) {
            const int e = it / 512, r = it % 512;
            if (r < 256)      transpose_item(p.w1 + (size_t)e * 1024 * 512, 1024, 512, W13, e * 1024, 2, 0, scr, r, lane);
            else              transpose_item(p.w3 + (size_t)e * 1024 * 512, 1024, 512, W13, e * 1024, 2, 1, scr, r - 256, lane);
        }
    }
}
__device__ __forceinline__ void moe_w2t(const Params& p, const LAS int* tab, LAS unsigned char* lds) {
    int tid = threadIdx.x; asm volatile("" : "+v"(tid));
    const int lane = tid & 63, wave = tid >> 6;
    LAS int* red = (LAS int*)(lds + LDS_MISC + 6144);
    const int NU = tab[64] * 4, per = (NU + 7) / 8, maxU = (per + 31) / 32, G = gridDim.x;
    int mine = 0, before = 0, total = 0;
    {
        int sl = 0;
        if (tid < G) { const int x = tid & 7, jj = tid >> 3; int px = NU - x * per; px = px < 0 ? 0 : (px > per ? per : px);
            const int u = px > jj ? (px - jj + 31) / 32 : 0; sl = maxU - u; }
        const float fb = wave_sum((tid < (int)blockIdx.x) ? (float)sl : 0.f), ft = wave_sum((float)sl), fm = wave_sum((tid == (int)blockIdx.x) ? (float)sl : 0.f);
        if (lane == 0) { red[wave] = (int)fb; red[8 + wave] = (int)ft; red[16 + wave] = (int)fm; }
        __syncthreads();
#pragma unroll
        for (int w = 0; w < 8; ++w) { before += red[w]; total += red[8 + w]; mine += red[16 + w]; }
    }
    if (total == 0) { mine = 1; before = blockIdx.x; total = G; }
    const int i0 = (int)((long)8192 * before / total), i1 = (int)((long)8192 * (before + mine) / total);
    LAS float* scr = (LAS float*)(lds + wave * 16384);
    bf16_t* W2T = (bf16_t*)(p.ws + OFF_U0 + 5 * USTR);
    for (int it = i0 + wave; it < i1; it += 8) { const int e = it >> 8, r = it & 255;
        transpose_item(p.w2 + (size_t)e * 512 * 1024, 512, 1024, W2T, e * 1024, 1, 0, scr, r, lane); }
}
__device__ __forceinline__ void moe_tables(const Params& p, LAS int* tab) {
    if (threadIdx.x == 0) {
        const int* gcnt = (const int*)(p.ws + OFF_GCNT); int acc = 0;
        for (int e = 0; e < 32; ++e) { const int c = gcnt[e]; tab[e] = c; tab[32 + e] = acc; acc += (c + 255) >> 8; }
        tab[64] = acc;
    }
    __syncthreads();
}
__device__ __forceinline__ void p8_final(const Params& p) {
    int tid = threadIdx.x; asm volatile("" : "+v"(tid));
    const int lane = tid & 63, gw = blockIdx.x * 8 + (tid >> 6), NGW = gridDim.x * 8;
    const bf16_t* Y0 = (const bf16_t*)(p.ws + OFF_U0 + 2 * USTR); const bf16_t* Y1 = (const bf16_t*)(p.ws + OFF_XB);
    const bf16_t* X1B = (const bf16_t*)(p.ws + OFF_U0 + 3 * USTR);
    f32x4 g4[4], b4[4];
#pragma unroll
    for (int j = 0; j < 4; ++j) { g4[j] = *(const f32x4*)(p.ln2_g + 4 * lane + 256 * j); b4[j] = *(const f32x4*)(p.ln2_b + 4 * lane + 256 * j); }
    f32x4 xa[4], xb_[4]; u32x2 ya0[4], ya1[4], yb0[4], yb1[4];
#define P8_LOAD(xs, y0s, y1s, row) do { \
        _Pragma("unroll") for (int j = 0; j < 4; ++j) { const u32x2 xw_ = *(const u32x2*)(X1B + (size_t)(row) * DM + 4 * lane + 256 * j); xs[j] = (f32x4){bflo(xw_.x), bfhi(xw_.x), bflo(xw_.y), bfhi(xw_.y)}; y0s[j] = *(const u32x2*)(Y0 + (size_t)(row) * DM + 4 * lane + 256 * j); y1s[j] = *(const u32x2*)(Y1 + (size_t)(row) * DM + 4 * lane + 256 * j); } } while (0)
#define P8_PROC(xs, y0s, y1s, row) do { f32x4* pr = (f32x4*)(p.out + (size_t)(row) * DM) + lane; f32x4 v[4]; float s = 0.f; \
        _Pragma("unroll") for (int j = 0; j < 4; ++j) { const u32x2 a = y0s[j], b = y1s[j]; \
            const f32x4 y = (f32x4){bflo(a.x) + bflo(b.x), bfhi(a.x) + bfhi(b.x), bflo(a.y) + bflo(b.y), bfhi(a.y) + bfhi(b.y)}; \
            v[j] = xs[j] * ALPHA + y; s += (v[j][0] + v[j][1]) + (v[j][2] + v[j][3]); } \
        const float mean = wave_sum(s) * (1.f / DM); float s2 = 0.f; \
        _Pragma("unroll") for (int j = 0; j < 4; ++j) { v[j] = v[j] - mean; s2 += (v[j][0] * v[j][0] + v[j][1] * v[j][1]) + (v[j][2] * v[j][2] + v[j][3] * v[j][3]); } \
        const float rstd = rsqrtf(wave_sum(s2) * (1.f / DM) + LN_EPS); \
        _Pragma("unroll") for (int j = 0; j < 4; ++j) pr[64 * j] = v[j] * rstd * g4[j] + b4[j]; } while (0)
    if (gw < T_TOK) P8_LOAD(xa, ya0, ya1, gw);
    for (int row = gw; row < T_TOK; row += 2 * NGW) {
        const int r1 = row + NGW, r2 = row + 2 * NGW;
        if (r1 < T_TOK) P8_LOAD(xb_, yb0, yb1, r1);
        P8_PROC(xa, ya0, ya1, row);
        if (r2 < T_TOK) P8_LOAD(xa, ya0, ya1, r2);
        if (r1 < T_TOK) P8_PROC(xb_, yb0, yb1, r1);
    }
#undef P8_LOAD
#undef P8_PROC
}

typedef const __attribute__((address_space(4))) Params* KPtr;
#if defined(__HIP_DEVICE_COMPILE__)
__device__ __forceinline__ KPtr KPP() { KPtr k = (KPtr)__builtin_amdgcn_kernarg_segment_ptr(); asm volatile("" : "+s"(k)); return k; }
#else
__device__ __forceinline__ KPtr KPP() { return (KPtr)0; }
#endif
#define KP() (*KPP())
__device__ __forceinline__ Params load_params() {
    KPtr k = KPP(); Params p;
    p.x = k->x; p.pos = k->pos; p.w_in = k->w_in; p.lb_logits = k->lb_logits; p.hg_norm_g = k->hg_norm_g; p.ret_norm_g = k->ret_norm_g;
    p.w_bh = k->w_bh; p.w_br = k->w_br; p.w_out = k->w_out; p.ln1_g = k->ln1_g; p.ln1_b = k->ln1_b; p.w_group = k->w_group; p.b_group = k->b_group;
    p.w_router = k->w_router; p.b_router = k->b_router; p.w1 = k->w1; p.w3 = k->w3; p.w2 = k->w2; p.ln2_g = k->ln2_g; p.ln2_b = k->ln2_b; p.out = k->out; p.ws = k->ws;
    return p;
}
#define WSP(off) (KP().ws + (size_t)(off))
#define UP(k) ((bf16_t*)(KP().ws + OFF_U0 + (size_t)(k) * USTR))
__device__ __forceinline__ void grid_bar(LAS unsigned char* lds) {
    XcdBarrier b; b.bar = (unsigned*)WSP(OFF_CTL); b.x = xb_xcc_id(); b.st = (volatile LAS unsigned*)(lds + LDS_XB);
    xcd_barrier(b);
}
__global__ void __launch_bounds__(512, 2) mega(Params p_unused) {
    extern __shared__ __attribute__((aligned(16))) unsigned char lds_raw[];
    LAS unsigned char* lds = (LAS unsigned char*)lds_raw;
    cg::grid_group grid = cg::this_grid();
    {
        volatile LAS unsigned* xbw = (volatile LAS unsigned*)(lds + LDS_XB);
        if (threadIdx.x < 16) xbw[threadIdx.x] = 0u;
        __syncthreads();
        (void)xcd_barrier_post((unsigned*)WSP(OFF_CTL), xbw);
    }
    { const Params p = load_params(); p0_prep(p, lds); }
    grid_bar(lds);
    if (KP().ws == nullptr) grid.sync();
    {
        SchedProj S; S.to.init(T_TOK, 4096); S.A = (const char*)WSP(OFF_XB); S.Bt = (const char*)WSP(OFF_WIN); S.col0 = 0; S.G = gridDim.x; S.c = blockIdx.x;
        S.kinds = (unsigned)ACT_SILU | (ACT_LOGF << 4) | (ACT_LOGF << 8) | (ACT_NONE << 12);
        EpiProj E{UP(0), (bf16_t*)KP().out, (const float*)WSP(OFF_LB), KP().pos, (const double*)WSP(OFF_INV), (bf16_t*)KP().out + TD, (bf16_t*)WSP(OFF_RG2), UP(4)};
        gemm_phase(lds, 1024, S, E);
    }
    grid_bar(lds);
    const bool full = gridDim.x == 256;
    const bool is_chain = full ? ((blockIdx.x & 7) < 4) : (blockIdx.x < 128);
    const int cbx = full ? (int)((blockIdx.x & 7) + 4 * (blockIdx.x >> 7)) : (int)(blockIdx.x & 7);
    const int hxq = full ? (int)(blockIdx.x & 7) - 4 : -1, hxj = (int)(blockIdx.x >> 3);
    if (is_chain) {
        if ((blockIdx.x >> 4) & 1) hgrn_fused<1>(UP(0), UP(2), UP(3), (bf16_t*)KP().out + TD, lds, cbx);
        else                       hgrn_fused<0>(UP(0), UP(1), UP(3), UP(5), lds, cbx);
    }
    if (!is_chain || gridDim.x < 256) {
        SchedGates2 S; S.xq = hxq; S.xj = hxj; S.to.init(T_TOK, 1024); S.A = (const char*)WSP(OFF_XB); S.Bt = (const char*)WSP(OFF_WIN);
        S.G = (gridDim.x < 256) ? gridDim.x : gridDim.x - 128; S.c = (gridDim.x < 256) ? blockIdx.x : blockIdx.x - 128;
        EpiProj E{UP(0), (bf16_t*)KP().out, (const float*)WSP(OFF_LB), KP().pos, (const double*)WSP(OFF_INV), (bf16_t*)KP().out + TD, (bf16_t*)WSP(OFF_RG2), UP(4)};
        gemm_phase(lds, 1024, S, E);
    }
    grid_bar(lds);
    p2c_norm_gate<128, true>(UP(5), (const bf16_t*)KP().out + TD, (const bf16_t*)KP().out, KP().hg_norm_g, (bf16_t*)KP().out);
    {
        SchedProjR S; S.to.init(T_TOK, 3072); S.A = (const char*)WSP(OFF_XB); S.Bt = (const char*)WSP(OFF_WIN); S.G = gridDim.x; S.c = blockIdx.x;
        EpiProj E{UP(0), (bf16_t*)KP().out, (const float*)WSP(OFF_LB), KP().pos, (const double*)WSP(OFF_INV), (bf16_t*)KP().out + TD, (bf16_t*)WSP(OFF_RG2), UP(4)};
        gemm_phase(lds, 1024, S, E);
    }
    grid_bar(lds);
    if (is_chain) {
        if ((blockIdx.x >> 5) & 1) ret_p2b<1>(UP(0), UP(1), UP(2), UP(3), lds, cbx);
        else                       ret_p2b<0>(UP(0), UP(1), UP(2), UP(5), lds, cbx);
    }
    if (!is_chain || gridDim.x < 256) {
        SchedRetHelp S; S.xq = hxq; S.xj = hxj; S.to.init(T_TOK, 1024); S.A = (const char*)WSP(OFF_XB); S.Bt = (const char*)WSP(OFF_WIN); S.ohg = (const char*)KP().out; S.wbh = (const char*)WSP(OFF_WBH);
        S.G = (gridDim.x < 256) ? gridDim.x : gridDim.x - 128; S.c = (gridDim.x < 256) ? blockIdx.x : blockIdx.x - 128;
        EpiRetHelp E{EpiProj{UP(0), (bf16_t*)KP().out, (const float*)WSP(OFF_LB), KP().pos, (const double*)WSP(OFF_INV), (bf16_t*)KP().out + TD, (bf16_t*)WSP(OFF_RG2), UP(4)},
                     EpiMix{UP(4), UP(2), UP(4), UP(0)}};
        gemm_phase(lds, 1024, S, E);
    }
    grid_bar(lds);
    p2c_norm_gate<256, true>(UP(5), UP(3), (const bf16_t*)KP().out + TD, KP().ret_norm_g, (bf16_t*)KP().out + TD);
    grid_bar(lds);
    {
        SchedMix S; S.to.init(T_TOK, 1024); S.xb = (const char*)WSP(OFF_XB); S.ohg = (const char*)KP().out; S.oret = (const char*)((bf16_t*)KP().out + TD); S.win = (const char*)WSP(OFF_WIN);
        S.wbh = (const char*)WSP(OFF_WBH); S.wbr = (const char*)WSP(OFF_WBR); S.G = gridDim.x; S.c = blockIdx.x;
        EpiMix E{UP(4), UP(2), UP(4), UP(0)};
        gemm_phase(lds, 1024, S, E);
    }
    grid_bar(lds);
    {
        SchedPlain S; S.to.init(T_TOK, 1024); S.A = (const char*)UP(0); S.Bt = (const char*)WSP(OFF_WO); S.G = gridDim.x; S.c = blockIdx.x; S.K = 1024;
        EpiPre1 E{KP().x, KP().out};
        gemm_phase(lds, 1024, S, E);
    }
    grid_bar(lds);
    { const Params p = load_params(); p5_router(p, lds); }
    grid_bar(lds);
    LAS int* tab = (LAS int*)(lds + LDS_MISC);
    { const Params p = load_params(); moe_tables(p, tab); }
    {
        SchedMoe1 S; S.tab = tab; S.G = gridDim.x; S.c = blockIdx.x; S.init_counts(); S.Abase = (const char*)UP(3); S.Bbase = (const char*)UP(4); S.b_estride = (size_t)1024 * 1024 * 2; S.K = 1024; S.gather = true;
        S.lent = (const int*)WSP(OFF_LENT);
        EpiMoe1 E{UP(0)};
        gemm_phase(lds, 1024, S, E);
    }
    { const Params p = load_params(); moe_w2t(p, tab, lds); }
    grid_bar(lds);
    {
        SchedMoe2 S; S.tab = tab; S.G = gridDim.x; S.c = blockIdx.x; S.init_counts(); S.Abase = (const char*)UP(0); S.Bbase = (const char*)UP(5); S.b_estride = (size_t)1024 * 512 * 2; S.K = 512; S.gather = false;
        S.lent = (const int*)WSP(OFF_LENT);
        EpiMoe2 E{UP(2), (long)((bf16_t*)WSP(OFF_XB) - UP(2)), (const int*)WSP(OFF_LENT), (const float*)WSP(OFF_LW), tab};
        gemm_phase(lds, 512, S, E);
    }
    grid_bar(lds);
    { const Params p = load_params(); p8_final(p); }
}

extern "C" void kernel_launch(void* const* d_in, const int* in_sizes, int n_in, void* d_out, int out_size, void* d_ws, size_t ws_size, hipStream_t stream) {
    static int grid_blocks = 0;
    if (!grid_blocks) {
        int dev = 0, cus = 0, per_cu = 0;
        (void)hipGetDevice(&dev);
        (void)hipDeviceGetAttribute(&cus, hipDeviceAttributeMultiprocessorCount, dev);
        (void)hipFuncSetAttribute((const void*)mega, hipFuncAttributeMaxDynamicSharedMemorySize, LDS_BYTES);
        (void)hipOccupancyMaxActiveBlocksPerMultiprocessor(&per_cu, (const void*)mega, 512, LDS_BYTES);
        if (per_cu < 1) per_cu = 1;
        grid_blocks = cus;
        fprintf(stderr, "grid %d (cus %d per_cu %d) ws %zu\n", grid_blocks, cus, per_cu, ws_size);
    }
    (void)hipMemsetAsync(d_ws, 0, CTL_ZERO_BYTES, stream);
    Params p{};
    p.x = (const float*)d_in[0]; p.pos = (const int*)d_in[1]; p.w_in = (const float*)d_in[2]; p.lb_logits = (const float*)d_in[3];
    p.hg_norm_g = (const float*)d_in[4]; p.ret_norm_g = (const float*)d_in[5]; p.w_bh = (const float*)d_in[6]; p.w_br = (const float*)d_in[7];
    p.w_out = (const float*)d_in[8]; p.ln1_g = (const float*)d_in[9]; p.ln1_b = (const float*)d_in[10]; p.w_group = (const float*)d_in[11];
    p.b_group = (const float*)d_in[12]; p.w_router = (const float*)d_in[13]; p.b_router = (const float*)d_in[14]; p.w1 = (const float*)d_in[15];
    p.w3 = (const float*)d_in[16]; p.w2 = (const float*)d_in[17]; p.ln2_g = (const float*)d_in[18]; p.ln2_b = (const float*)d_in[19];
    p.out = (float*)d_out; p.ws = (unsigned char*)d_ws;
    void* args[] = {&p};
    hipError_t e = hipLaunchCooperativeKernel((const void*)mega, dim3(grid_blocks), dim3(512), args, LDS_BYTES, stream);
    if (e != hipSuccess) fprintf(stderr, "cooperative launch failed: %s (grid %d)\n", hipGetErrorString(e), grid_blocks);
}
```
